# Optimizing an MI355X kernel written in HIP

```python
import math
import jax, jax.numpy as jnp
from jax import lax
import numpy as np

D_MODEL = 1024
BATCH = 2
SEQ = 8192
DEPTH = 1

D_PLE = 256
D_ATTN = D_MODEL // 2
HEAD_DIM = 64
N_ATTN_HEADS = D_ATTN // HEAD_DIM
D_POOL = D_MODEL - D_ATTN
POOL_WINDOWS = (2, 4, 8, 16)
N_POOL_GROUPS = len(POOL_WINDOWS)
POOL_GROUP_DIM = D_POOL // N_POOL_GROUPS
D_MIX = D_ATTN + D_POOL
D_IN_PROJ = 3 * D_ATTN + D_POOL
MOBA_BLOCK = 256
MOBA_TOPK = 3
Q_CHUNK = 64
REL_BUCKETS = 32
REL_MAX_DIST = 128
N_EXPERT_GROUPS = 4
EXPERTS_PER_GROUP = 8
D_EXPERT = 512
TOP_K_INNER = 2
RMS_EPS = 1e-6

kernel_name = "hymba_moba_pool_hiermoe_block"


def rms_norm(x, g):
    xf = x.astype(jnp.float32)
    y = xf * lax.rsqrt(jnp.mean(xf * xf, axis=-1, keepdims=True) + RMS_EPS)
    return (y * g.astype(jnp.float32)).astype(x.dtype)


def rel_bucket(n):
    n = jnp.maximum(n, 0)
    max_exact = REL_BUCKETS // 2
    nf = jnp.maximum(n, 1).astype(jnp.float32)
    large = max_exact + (jnp.log(nf / max_exact) / math.log(REL_MAX_DIST / max_exact)
                         * (REL_BUCKETS - max_exact)).astype(jnp.int32)
    large = jnp.minimum(large, REL_BUCKETS - 1)
    return jnp.where(n < max_exact, n, large)


def moba_attention(q, k, v, rel_bias):
    B, S, H, hd = q.shape
    nb = -(-S // MOBA_BLOCK)
    s_pad = nb * MOBA_BLOCK
    pad = ((0, 0), (0, s_pad - S), (0, 0), (0, 0))
    q, k, v = (jnp.pad(t, pad).transpose(0, 2, 1, 3) for t in (q, k, v))
    kb = k.reshape(B, H, nb, MOBA_BLOCK, hd)
    vb = v.reshape(B, H, nb, MOBA_BLOCK, hd)
    kmean = jnp.mean(kb.astype(jnp.float32), axis=3)
    k_sel = min(MOBA_TOPK, max(nb - 1, 1))
    scale = HEAD_DIM ** -0.5
    bias_ht = rel_bias.T.astype(jnp.float32)
    n_chunks = s_pad // Q_CHUNK
    qc = jnp.moveaxis(q.reshape(B, H, n_chunks, Q_CHUNK, hd), 2, 0)
    b_ix = jnp.arange(B)[:, None, None, None]
    h_ix = jnp.arange(H)[None, :, None, None]
    h_ix5 = h_ix[..., None]
    blk_ar = jnp.arange(MOBA_BLOCK)

    def chunk_fn(args):
        ci, q_c = args
        q0 = ci * Q_CHUNK
        ob = q0 // MOBA_BLOCK
        q_pos = q0 + jnp.arange(Q_CHUNK)
        qf = q_c.astype(jnp.float32)
        gate = jnp.einsum('bhqd,bhnd->bhqn', qf, kmean)
        gate = jnp.where(jnp.arange(nb) < ob, gate, -jnp.inf)
        _, idx = lax.top_k(gate, k_sel)
        valid = idx < ob
        k_g = kb[b_ix, h_ix, idx].astype(jnp.float32)
        v_g = vb[b_ix, h_ix, idx].astype(jnp.float32)
        s_sel = jnp.einsum('bhqd,bhqknd->bhqkn', qf, k_g) * scale
        key_pos_sel = idx[..., None] * MOBA_BLOCK + blk_ar
        bucket_sel = rel_bucket(q_pos[None, None, :, None, None] - key_pos_sel)
        s_sel = s_sel + bias_ht[h_ix5, bucket_sel]
        s_sel = jnp.where(valid[..., None], s_sel, -jnp.inf)
        k_own = lax.dynamic_index_in_dim(kb, ob, axis=2, keepdims=False).astype(jnp.float32)
        v_own = lax.dynamic_index_in_dim(vb, ob, axis=2, keepdims=False).astype(jnp.float32)
        dist_own = q_pos[:, None] - (ob * MOBA_BLOCK + blk_ar)[None, :]
        s_own = (jnp.einsum('bhqd,bhnd->bhqn', qf, k_own) * scale
                 + bias_ht[:, rel_bucket(dist_own)])
        s_own = jnp.where(dist_own >= 0, s_own, -jnp.inf)
        logits = jnp.concatenate(
            [s_sel.reshape(B, H, Q_CHUNK, k_sel * MOBA_BLOCK), s_own], axis=-1)
        probs = jax.nn.softmax(logits, axis=-1)
        p_sel = probs[..., :k_sel * MOBA_BLOCK].reshape(B, H, Q_CHUNK, k_sel, MOBA_BLOCK)
        p_own = probs[..., k_sel * MOBA_BLOCK:]
        out = (jnp.einsum('bhqkn,bhqknd->bhqd', p_sel, v_g)
               + jnp.einsum('bhqn,bhnd->bhqd', p_own, v_own))
        return out.astype(q_c.dtype)

    out = lax.map(chunk_fn, (jnp.arange(n_chunks, dtype=jnp.int32), qc))
    out = out.transpose(1, 0, 3, 2, 4).reshape(B, s_pad, H * hd)
    return out[:, :S]


def causal_pool_mixer(u, w_pool, pool_scale):
    B, S, _ = u.shape
    uf = u.astype(jnp.float32)
    cs = jnp.concatenate([jnp.zeros((B, 1, D_POOL), jnp.float32), jnp.cumsum(uf, axis=1)], axis=1)
    t = jnp.arange(S)
    means = []
    for gi, w in enumerate(POOL_WINDOWS):
        c = cs[..., gi * POOL_GROUP_DIM:(gi + 1) * POOL_GROUP_DIM]
        start = jnp.maximum(t + 1 - w, 0)
        cnt = (t + 1 - start).astype(jnp.float32)[None, :, None]
        means.append((c[:, 1:] - c[:, start]) / cnt)
    pooled = (jnp.concatenate(means, axis=-1) - uf).reshape(B, S, N_POOL_GROUPS, POOL_GROUP_DIM)
    y = jnp.einsum('bsgc,gcd->bsgd', pooled, w_pool.astype(jnp.float32)).reshape(B, S, D_POOL)
    return (y * pool_scale.astype(jnp.float32)).astype(u.dtype)


def hier_moe(h, w_r1, b_r1, w_r2, b_r2, w_gate, w_up, w_down):
    B, S, D = h.shape
    hf = h.reshape(-1, D)
    logits1 = jnp.dot(hf, w_r1).astype(jnp.float32) + b_r1.astype(jnp.float32)
    p1 = jax.nn.softmax(logits1, axis=-1)
    g_sel = jnp.argmax(logits1, axis=-1)
    p_g = jnp.take_along_axis(p1, g_sel[:, None], axis=-1)[:, 0]
    logits2 = (jnp.einsum('td,gde->tge', hf, w_r2).astype(jnp.float32)
               + b_r2.astype(jnp.float32))
    l2 = jnp.take_along_axis(logits2, g_sel[:, None, None], axis=1)[:, 0]
    top_v, top_i = lax.top_k(l2, TOP_K_INNER)
    w2 = jax.nn.softmax(top_v, axis=-1)
    inner = jnp.sum(jax.nn.one_hot(top_i, EXPERTS_PER_GROUP, dtype=jnp.float32) * w2[..., None], axis=1)
    gates = (jax.nn.one_hot(g_sel, N_EXPERT_GROUPS, dtype=jnp.float32)[:, :, None]
             * (p_g[:, None] * inner)[:, None, :])
    y = jnp.zeros(hf.shape, jnp.float32)
    for g in range(N_EXPERT_GROUPS):
        a = jnp.einsum('td,edf->tef', hf, w_gate[g])
        u = jnp.einsum('td,edf->tef', hf, w_up[g])
        hid = (jax.nn.silu(a.astype(jnp.float32)) * u.astype(jnp.float32)
               * gates[:, g, :, None])
        y = y + jnp.einsum('tef,efd->td', hid.astype(h.dtype), w_down[g]).astype(jnp.float32)
    return y.astype(h.dtype).reshape(B, S, D)


def setup_inputs(seed: int = 0) -> dict:
    key = jax.random.key(seed)
    ks = jax.random.split(key, 24)
    f32 = jnp.float32
    nrm = lambda k, shape, s: jax.random.normal(k, shape, f32) * s
    L, G, E = DEPTH, N_EXPERT_GROUPS, EXPERTS_PER_GROUP
    return {
        "x": nrm(ks[0], (BATCH, SEQ, D_MODEL), 1.0),
        "p": nrm(ks[1], (DEPTH, BATCH, SEQ, D_PLE), 1.0),
        "g_mix": 1.0 + nrm(ks[2], (L, D_MODEL), 0.05),
        "w_in": nrm(ks[3], (L, D_MODEL, D_IN_PROJ), D_MODEL ** -0.5),
        "w_pool": nrm(ks[4], (L, N_POOL_GROUPS, POOL_GROUP_DIM, POOL_GROUP_DIM), POOL_GROUP_DIM ** -0.5),
        "pool_scale": 1.0 + nrm(ks[5], (L, D_POOL), 0.1),
        "w_out": nrm(ks[6], (L, D_MIX, D_MODEL), D_MIX ** -0.5),
        "rel_bias": nrm(ks[7], (REL_BUCKETS, N_ATTN_HEADS), 0.5),
        "g_ffn": 1.0 + nrm(ks[8], (L, D_MODEL), 0.05),
        "w_r1": nrm(ks[9], (L, D_MODEL, G), D_MODEL ** -0.5),
        "b_r1": nrm(ks[10], (L, G), 0.01),
        "w_r2": nrm(ks[11], (L, G, D_MODEL, E), D_MODEL ** -0.5),
        "b_r2": nrm(ks[12], (L, G, E), 0.01),
        "w_gate": nrm(ks[13], (L, G, E, D_MODEL, D_EXPERT), D_MODEL ** -0.5),
        "w_up": nrm(ks[14], (L, G, E, D_MODEL, D_EXPERT), D_MODEL ** -0.5),
        "w_down": nrm(ks[15], (L, G, E, D_EXPERT, D_MODEL), D_EXPERT ** -0.5),
        "g_ple": 1.0 + nrm(ks[16], (L, D_MODEL), 0.05),
        "w_ple_proj": nrm(ks[17], (L, D_PLE, D_MODEL), D_PLE ** -0.5),
        "w_ple_gate": nrm(ks[18], (L, D_MODEL, D_MODEL), D_MODEL ** -0.5),
        "g_final": 1.0 + nrm(ks[19], (D_MODEL,), 0.05),
    }


def reference(x, p, g_mix, w_in, w_pool, pool_scale, w_out, rel_bias, g_ffn, w_r1, b_r1,
              w_r2, b_r2, w_gate, w_up, w_down, g_ple, w_ple_proj, w_ple_gate, g_final):
    B, S, _ = x.shape
    for i in range(DEPTH):
        h = rms_norm(x, g_mix[i])
        z = jnp.dot(h, w_in[i])
        q = z[..., :D_ATTN].reshape(B, S, N_ATTN_HEADS, HEAD_DIM)
        k = z[..., D_ATTN:2 * D_ATTN].reshape(B, S, N_ATTN_HEADS, HEAD_DIM)
        v = z[..., 2 * D_ATTN:3 * D_ATTN].reshape(B, S, N_ATTN_HEADS, HEAD_DIM)
        u = z[..., 3 * D_ATTN:]
        a = moba_attention(q, k, v, rel_bias)
        b = causal_pool_mixer(u, w_pool[i], pool_scale[i])
        x = x + jnp.dot(jnp.concatenate([a, b], axis=-1), w_out[i])
        x = x + hier_moe(rms_norm(x, g_ffn[i]), w_r1[i], b_r1[i], w_r2[i], b_r2[i],
                         w_gate[i], w_up[i], w_down[i])
        gate = jax.nn.sigmoid(jnp.dot(rms_norm(x, g_ple[i]), w_ple_gate[i]).astype(jnp.float32))
        x = x + (jnp.dot(p[i], w_ple_proj[i]).astype(jnp.float32) * gate).astype(x.dtype)
    return rms_norm(x, g_final)
```

```cpp
#include <hip/hip_runtime.h>
#include <stdint.h>
#include <stdio.h>

#define DI __device__ __forceinline__
#define LAS __attribute__((address_space(3)))

typedef unsigned short bf16_t;
typedef short bf16x8 __attribute__((ext_vector_type(8)));
typedef short s16x4 __attribute__((ext_vector_type(4)));
typedef float f32x2 __attribute__((ext_vector_type(2)));
typedef float f32x4 __attribute__((ext_vector_type(4)));
typedef float f32x16 __attribute__((ext_vector_type(16)));
typedef unsigned u32x2 __attribute__((ext_vector_type(2)));
typedef unsigned u32x4 __attribute__((ext_vector_type(4)));

constexpr int T = 16384, D = 1024, SEQ = 8192, NH = 8, NBLK = 32;
constexpr int ZLD = 2048;
constexpr float EPS = 1e-6f;
constexpr float LOG2E = 1.4426950408889634f;
constexpr int NT = 512;
#define PH(k) (((MASK) >> (k)) & 1)
#ifndef PROF_PHASES
#define PROF_PHASES 0
#endif

constexpr size_t MiB = 1u << 20;
constexpr size_t WS_CTL = 0, CTL_BYTES = 1 * MiB;
constexpr size_t OFF_CNT_SEL = 16384;
constexpr size_t OFF_CNT_EXP = 20480;
constexpr size_t OFF_PCNT = 24576;
constexpr size_t OFF_SS1 = 65536;
constexpr size_t OFF_SS3 = 131072;
constexpr size_t WS_KMEAN = 1 * MiB;
constexpr size_t WS_TAB = WS_KMEAN + 131072;
constexpr size_t WS_RSTD0 = WS_KMEAN + 196608;
constexpr size_t WS_RSTD2 = WS_KMEAN + 262144;
constexpr size_t WS_RB = WS_KMEAN + 327680;
constexpr size_t WS_SS1P = 2 * MiB;
constexpr size_t WS_WIN = 4 * MiB;
constexpr size_t WS_WOUT = 8 * MiB;
constexpr size_t WS_WPG = 10 * MiB;
constexpr size_t WS_WPLE = 12 * MiB;
constexpr size_t WS_WPOOL = 12 * MiB + 524288;
constexpr size_t WS_WR = 12 * MiB + 786432;
constexpr size_t WS_XB = 16 * MiB;
constexpr size_t WS_Z = 48 * MiB;
constexpr size_t WS_TOK = 112 * MiB;
constexpr size_t WS_GW = 114 * MiB;
constexpr size_t WS_SEL = 128 * MiB;
constexpr size_t WS_PARTO = 144 * MiB;
constexpr size_t WS_PARTML = 192 * MiB;
constexpr size_t WS_AB = 197 * MiB;
constexpr size_t WS_PB = 229 * MiB;
constexpr size_t WS_PP = 237 * MiB;
constexpr size_t WS_END = 269 * MiB;

constexpr int LDS_MISC = 131072;
constexpr int LDS_BYTES = 163840;
constexpr int MISC_ARR = 64;
constexpr int MISC_TAB = 4096;
constexpr int MISC_DESC = 8704;
constexpr int MISC_STG = 12288;

DI unsigned pk2(float lo, float hi) {
    typedef __bf16 b2 __attribute__((ext_vector_type(2)));
    f32x2 v = {lo, hi};
    b2 b = __builtin_convertvector(v, b2);
    return __builtin_bit_cast(unsigned, b);
}
DI float bflo(unsigned w) { return __uint_as_float(w << 16); }
DI float bfhi(unsigned w) { return __uint_as_float(w & 0xffff0000u); }
DI float wave_sum(float v) {
#pragma unroll
    for (int o = 1; o < 64; o <<= 1) v += __shfl_xor(v, o);
    return v;
}
DI f32x4 mfma16(bf16x8 a, bf16x8 b, f32x4 c) { return __builtin_amdgcn_mfma_f32_16x16x32_bf16(a, b, c, 0, 0, 0); }
DI f32x16 mfma32(bf16x8 a, bf16x8 b, f32x16 c) { return __builtin_amdgcn_mfma_f32_32x32x16_bf16(a, b, c, 0, 0, 0); }
DI float fast_exp2(float x) { return __builtin_amdgcn_exp2f(x); }
DI float fast_rcp(float x) { return __builtin_amdgcn_rcpf(x); }

#define XB_TMO      128
#define XB_XCNT(j)  (256  + 64 * (j))
#define XB_XSUB(j)  (1280 + 64 * (j))
#define XB_XGEN(j)  (2304 + 64 * (j))
#define XB_TOP      3328
#define XB_TOPGEN   3392
#define XCD_BAR_WORDS 3456
#define XB_SPIN_CAP (1u << 18)
DI unsigned xb_ld(unsigned* p)              { return __hip_atomic_load(p, __ATOMIC_RELAXED, __HIP_MEMORY_SCOPE_AGENT); }
DI unsigned xb_add(unsigned* p, unsigned v) { return __hip_atomic_fetch_add(p, v, __ATOMIC_RELAXED, __HIP_MEMORY_SCOPE_AGENT); }
DI unsigned xb_xcc_id() { return (unsigned)__builtin_amdgcn_s_getreg((3 << 11) | 20) & 0xFu; }
#define XB_SPIN(cond, bar) do { unsigned _sp = 0; while (cond) { __builtin_amdgcn_s_sleep(1); \
    if ((++_sp & 255u) == 0u) { if (xb_ld(&(bar)[XB_TMO])) break; if (_sp > XB_SPIN_CAP) { atomicAdd(&(bar)[XB_TMO], 1u); break; } } } } while (0)
struct XcdBarrier { unsigned* bar; unsigned x; volatile LAS unsigned* st; };
DI XcdBarrier xcd_barrier_post(unsigned* bar, volatile LAS unsigned* st) {
    XcdBarrier b; b.bar = bar; b.x = xb_xcc_id(); b.st = st;
    if (threadIdx.x == 0) (void)xb_add(&bar[XB_XCNT(b.x)], 1u);
    return b;
}
DI void xcd_barrier_complete(unsigned* bar, unsigned x, unsigned& nloc, unsigned& nx) {
    const unsigned G = gridDim.x * gridDim.y * gridDim.z;
    unsigned sum, cnt, mine, sp = 0u;
    for (;;) {
        sum = 0u; cnt = 0u; mine = 0u;
#pragma unroll
        for (unsigned j = 0; j < 16; ++j) { const unsigned c = xb_ld(&bar[XB_XCNT(j)]); sum += c; cnt += (c > 0u) ? 1u : 0u; mine = (j == x) ? c : mine; }
        if (sum == G) break;
        __builtin_amdgcn_s_sleep(1);
        if ((++sp & 255u) == 0u) { if (xb_ld(&bar[XB_TMO])) break; if (sp > XB_SPIN_CAP) { atomicAdd(&bar[XB_TMO], 1u); break; } }
    }
    nloc = mine > 0u ? mine : 1u; nx = cnt > 0u ? cnt : 1u;
}
DI void xcd_barrier(const XcdBarrier& b) {
    asm volatile("s_waitcnt vmcnt(0)" ::: "memory");
    __syncthreads();
    if (threadIdx.x == 0) {
        unsigned* bar = b.bar;
        __builtin_amdgcn_s_waitcnt(0);
        unsigned nloc = b.st[0], nx = b.st[1];
        if (nloc == 0u) { xcd_barrier_complete(bar, b.x, nloc, nx); b.st[0] = nloc; b.st[1] = nx; }
        const unsigned old = xb_add(&bar[XB_XSUB(b.x)], 1u);
        const unsigned gen = old / nloc;
        if (old + 1u == (gen + 1u) * nloc) {
            __builtin_amdgcn_fence(__ATOMIC_RELEASE, "agent");
            asm volatile("s_waitcnt vmcnt(0)" ::: "memory");
            const unsigned og = xb_add(&bar[XB_TOP], 1u);
            const unsigned tg = og / nx;
            if (og + 1u == (tg + 1u) * nx) xb_add(&bar[XB_TOPGEN], 1u);
            else XB_SPIN(xb_ld(&bar[XB_TOPGEN]) == tg, bar);
            __builtin_amdgcn_fence(__ATOMIC_ACQUIRE, "agent");
            xb_add(&bar[XB_XGEN(b.x)], 1u);
            asm volatile("s_waitcnt vmcnt(0)" ::: "memory");
        } else {
            XB_SPIN(xb_ld(&bar[XB_XGEN(b.x)]) == gen, bar);
            __builtin_amdgcn_fence(__ATOMIC_ACQUIRE, "agent");
            asm volatile("s_waitcnt vmcnt(0)" ::: "memory");
        }
    }
    __syncthreads();
}

constexpr int G8_HTB = 16384;
DI int g8_lds_byte(int r, int c) { const int st = (r >> 4) * 2 + (c >> 5), rr = r & 15, cc = c & 31, ob = rr * 64 + cc * 2; return st * 1024 + (ob ^ (((ob >> 9) & 1) << 5)); }
DI void g8_stage_rc(int b, int& R, int& C) { const int st = b / 1024, sb = b % 1024, swz = sb ^ (((sb >> 9) & 1) << 5); R = (st >> 1) * 16 + swz / 64; C = (st & 1) * 32 + (swz % 64) / 2; }
struct GUnit { int pm, pn, e, cnt; const unsigned char* bptr; };
template <class Sched, class Epi>
DI void gemm8(LAS unsigned char* lds, const unsigned char* Abase, const int K, const Sched& S, const Epi& E) {
    const int tid = threadIdx.x, wid = __builtin_amdgcn_readfirstlane(tid >> 6), lane = tid & 63, wr = wid >> 2, wc = wid & 3, fr = lane & 15, fq = lane >> 4;
    const int nt = K / 64;
    int sR[2], sC[2]; unsigned voffB[2];
#pragma unroll
    for (int i = 0; i < 2; ++i) { g8_stage_rc(tid * 16 + i * 8192, sR[i], sC[i]);
        const int rho = sR[i] & 31, rb = (sR[i] & ~31) + 8 * ((rho & 15) >> 2) + 4 * (rho >> 4) + (rho & 3);
        voffB[i] = (unsigned)(rb * K + sC[i]) * 2u; }
    const unsigned kstep = 128u;
    const size_t hstep = (size_t)128 * K * 2;
    const unsigned ldsw = (unsigned)wid * 1024u;
    const int aoff = g8_lds_byte(wr * 64 + fr, fq * 8), boff = g8_lds_byte(wc * 32 + fr, fq * 8);
#define G8_SA(b, h) (((b) * 2 + (h)) * G8_HTB)
#define G8_SB(b, h) ((4 + (b) * 2 + (h)) * G8_HTB)
#define G8_STAGE_B(bufoff, gbase) do { _Pragma("unroll") for (int _i = 0; _i < 2; ++_i) \
        __builtin_amdgcn_global_load_lds((const unsigned*)((gbase) + voffB[_i]), (LAS unsigned*)(lds + (bufoff) + ldsw + _i * 8192), 16, 0, 0); } while (0)
#define G8_STAGE_A(bufoff, o0, o1, kb) do { \
        __builtin_amdgcn_global_load_lds((const unsigned*)(Abase + (o0) + (kb)), (LAS unsigned*)(lds + (bufoff) + ldsw), 16, 0, 0); \
        __builtin_amdgcn_global_load_lds((const unsigned*)(Abase + (o1) + (kb)), (LAS unsigned*)(lds + (bufoff) + ldsw + 8192), 16, 0, 0); } while (0)
#define G8_LDA(dst, b, h) do { _Pragma("unroll") for (int m = 0; m < 4; ++m) _Pragma("unroll") for (int k = 0; k < 2; ++k) dst[m][k] = *(const LAS bf16x8*)(lds + G8_SA(b, h) + aoff + m * 2048 + k * 1024); } while (0)
#define G8_LDB(dst, b, h) do { _Pragma("unroll") for (int n = 0; n < 2; ++n) _Pragma("unroll") for (int k = 0; k < 2; ++k) dst[n][k] = *(const LAS bf16x8*)(lds + G8_SB(b, h) + boff + n * 2048 + k * 1024); } while (0)
#define G8_MMA(ai, bj, At, Bt) do { __builtin_amdgcn_s_setprio(1); _Pragma("unroll") for (int m = 0; m < 4; ++m) _Pragma("unroll") for (int n = 0; n < 2; ++n) _Pragma("unroll") for (int k = 0; k < 2; ++k) \
        acc[ai][bj][m][n] = __builtin_amdgcn_mfma_f32_16x16x32_bf16(Bt[n][k], At[m][k], acc[ai][bj][m][n], 0, 0, 0); __builtin_amdgcn_s_setprio(0); } while (0)
#define G8_WAIT_V(n) asm volatile("s_waitcnt vmcnt(" #n ")" ::: "memory")
#define G8_WAIT_L(n) asm volatile("s_waitcnt lgkmcnt(" #n ")" ::: "memory")
#define G8_BAR __builtin_amdgcn_s_barrier()
#define G8_SCHED __builtin_amdgcn_sched_barrier(0)
    GUnit cur, nxt; int ui = 0;
    if (!S.next(0, cur)) return;
    f32x4 acc[2][2][4][2];
#pragma unroll
    for (int a = 0; a < 2; ++a)
#pragma unroll
        for (int b = 0; b < 2; ++b)
#pragma unroll
            for (int m = 0; m < 4; ++m)
#pragma unroll
                for (int n = 0; n < 2; ++n) acc[a][b][m][n] = (f32x4){0.f, 0.f, 0.f, 0.f};
    bf16x8 At[4][2], B0[2][2], B1[2][2];
    unsigned oc[2][2], on[2][2];
    S.aoffs(cur, sR, sC, oc);
    const unsigned char* cB = cur.bptr;
    G8_STAGE_B(G8_SB(0, 0), cB); G8_STAGE_B(G8_SB(0, 1), cB + hstep); G8_STAGE_A(G8_SA(0, 0), oc[0][0], oc[0][1], 0u); G8_STAGE_A(G8_SA(0, 1), oc[1][0], oc[1][1], 0u);
    if (wr == 1) G8_BAR;
    G8_WAIT_V(2); G8_BAR;
    G8_STAGE_B(G8_SB(1, 0), cB + kstep); G8_STAGE_A(G8_SA(1, 0), oc[0][0], oc[0][1], kstep); G8_STAGE_B(G8_SB(1, 1), cB + hstep + kstep);
    G8_WAIT_V(6); G8_BAR;
    for (;;) {
        const bool has_next = S.next(ui + 1, nxt);
        if (has_next) S.aoffs(nxt, sR, sC, on);
        else {
#pragma unroll
            for (int h = 0; h < 2; ++h)
#pragma unroll
                for (int i = 0; i < 2; ++i) on[h][i] = oc[h][i];
        }
        const unsigned char* nB = has_next ? nxt.bptr : cB;
#pragma unroll 1
        for (int t = 0; t < nt; t += 2) {
            const bool last = (t == nt - 2);
            const unsigned k1 = (unsigned)(t + 1) * kstep;
            const unsigned k2 = last ? 0u : (unsigned)(t + 2) * kstep, k3 = k2 + kstep;
            const unsigned a2_00 = last ? on[0][0] : oc[0][0], a2_01 = last ? on[0][1] : oc[0][1], a2_10 = last ? on[1][0] : oc[1][0], a2_11 = last ? on[1][1] : oc[1][1];
            const unsigned char* b2 = (last ? nB : cB) + k2; const unsigned char* b3 = b2 + kstep;
            G8_LDB(B0, 0, 0); G8_LDB(B1, 0, 1); G8_SCHED; G8_LDA(At, 0, 0); G8_STAGE_A(G8_SA(1, 1), oc[1][0], oc[1][1], k1);
            G8_WAIT_V(8); G8_WAIT_L(0); G8_BAR; G8_MMA(0, 0, At, B0); G8_MMA(0, 1, At, B1); G8_BAR; G8_SCHED;
            G8_LDA(At, 0, 1); G8_STAGE_B(G8_SB(0, 0), b2); G8_STAGE_B(G8_SB(0, 1), b2 + hstep); G8_STAGE_A(G8_SA(0, 0), a2_00, a2_01, k2);
            G8_WAIT_V(8); G8_WAIT_L(0); G8_BAR; G8_MMA(1, 0, At, B0); G8_MMA(1, 1, At, B1); G8_BAR; G8_SCHED;
            G8_LDB(B0, 1, 0); G8_LDB(B1, 1, 1); G8_SCHED; G8_LDA(At, 1, 0); G8_STAGE_A(G8_SA(0, 1), a2_10, a2_11, k2);
            G8_WAIT_V(8); G8_WAIT_L(0); G8_BAR; G8_MMA(0, 0, At, B0); G8_MMA(0, 1, At, B1); G8_BAR; G8_SCHED;
            G8_LDA(At, 1, 1); G8_STAGE_B(G8_SB(1, 0), b3); G8_STAGE_B(G8_SB(1, 1), b3 + hstep); G8_STAGE_A(G8_SA(1, 0), a2_00, a2_01, k3);
            G8_WAIT_V(8); G8_WAIT_L(0); G8_BAR; G8_MMA(1, 0, At, B0); G8_MMA(1, 1, At, B1); G8_BAR; G8_SCHED;
        }
        if (wr == 0) G8_BAR;
        E(acc, cur, wr, wc, fr, fq);
        if (!has_next) break;
#pragma unroll
        for (int a = 0; a < 2; ++a)
#pragma unroll
            for (int b = 0; b < 2; ++b)
#pragma unroll
                for (int m = 0; m < 4; ++m)
#pragma unroll
                    for (int n = 0; n < 2; ++n) acc[a][b][m][n] = (f32x4){0.f, 0.f, 0.f, 0.f};
        cur = nxt; cB = nB; ++ui;
#pragma unroll
        for (int h = 0; h < 2; ++h)
#pragma unroll
            for (int i = 0; i < 2; ++i) oc[h][i] = on[h][i];
        if (wr == 1) G8_BAR;
    }
    G8_WAIT_V(0);
    G8_BAR;
#undef G8_SA
#undef G8_SB
#undef G8_STAGE_A
#undef G8_STAGE_B
#undef G8_LDA
#undef G8_LDB
#undef G8_MMA
#undef G8_WAIT_V
#undef G8_WAIT_L
#undef G8_BAR
#undef G8_SCHED
}
template <int W>
DI void pool_build(LAS unsigned char* lds, const bf16_t* z, int mt, int g) {
    const int tid = threadIdx.x, ch16 = tid & 15, r0 = (tid >> 4) * 8;
    const int t0 = mt * 256 + r0, s0 = t0 & (SEQ - 1);
    const bf16_t* up = z + (size_t)t0 * ZLD + 1536 + g * 128 + ch16 * 8;
    u32x4 rows[W + 7];
#pragma unroll
    for (int j = 0; j < W + 7; ++j) {
        const int d = j - (W - 1);
        rows[j] = (s0 + d >= 0) ? *(const u32x4*)(up + (ptrdiff_t)d * ZLD) : (u32x4){0u, 0u, 0u, 0u};
    }
    float a8[8];
#pragma unroll
    for (int q = 0; q < 8; ++q) a8[q] = 0.f;
#pragma unroll
    for (int j = 0; j < W - 1; ++j) { const u32x4 v = rows[j];
        a8[0] += bflo(v.x); a8[1] += bfhi(v.x); a8[2] += bflo(v.y); a8[3] += bfhi(v.y); a8[4] += bflo(v.z); a8[5] += bfhi(v.z); a8[6] += bflo(v.w); a8[7] += bfhi(v.w); }
#pragma unroll
    for (int i = 0; i < 8; ++i) {
        const u32x4 cur = rows[W - 1 + i];
        a8[0] += bflo(cur.x); a8[1] += bfhi(cur.x); a8[2] += bflo(cur.y); a8[3] += bfhi(cur.y); a8[4] += bflo(cur.z); a8[5] += bfhi(cur.z); a8[6] += bflo(cur.w); a8[7] += bfhi(cur.w);
        const int s = s0 + i, row = r0 + i;
        const float rc = 1.0f / (float)((s + 1 < W) ? (s + 1) : W);
        const u32x4 o = {pk2(a8[0] * rc - bflo(cur.x), a8[1] * rc - bfhi(cur.x)), pk2(a8[2] * rc - bflo(cur.y), a8[3] * rc - bfhi(cur.y)),
                         pk2(a8[4] * rc - bflo(cur.z), a8[5] * rc - bfhi(cur.z)), pk2(a8[6] * rc - bflo(cur.w), a8[7] * rc - bfhi(cur.w))};
        *(LAS u32x4*)(lds + (ch16 >> 3) * 49152 + row * 128 + (((ch16 & 7) ^ (row & 7)) << 4)) = o;
        const u32x4 old = rows[i];
        a8[0] -= bflo(old.x); a8[1] -= bfhi(old.x); a8[2] -= bflo(old.y); a8[3] -= bfhi(old.y); a8[4] -= bflo(old.z); a8[5] -= bfhi(old.z); a8[6] -= bflo(old.w); a8[7] -= bfhi(old.w);
    }
}
DI void pool_unit(f32x4 (&acc)[4][4], LAS unsigned char* lds, const bf16_t* z, int mt, int g, const unsigned char* Bb, const unsigned (&boff)[2]) {
    const int tid = threadIdx.x, lane = tid & 63;
    const int wave = __builtin_amdgcn_readfirstlane(tid >> 6), wm = wave >> 1, wn = wave & 1;
    const int fr = lane & 15, fq = lane >> 4;
    const unsigned xk0 = (unsigned)((fq ^ (lane & 7)) << 4), xk1 = (unsigned)(((4 + fq) ^ (lane & 7)) << 4);
    const unsigned ard = (unsigned)(wm * 64 + fr) * 128u, brd = 32768u + (unsigned)(wn * 64 + fr) * 128u;
    const unsigned wbase = (unsigned)wave * 1024u;
    __syncthreads();
#pragma unroll
    for (int st = 0; st < 2; ++st)
#pragma unroll
        for (int i = 0; i < 2; ++i)
            __builtin_amdgcn_global_load_lds((const unsigned*)(Bb + boff[i] + (unsigned)st * 128u), (LAS unsigned*)(lds + st * 49152 + 32768 + wbase + i * 8192), 16, 0, 0);
    if (g == 0) pool_build<2>(lds, z, mt, g); else if (g == 1) pool_build<4>(lds, z, mt, g); else if (g == 2) pool_build<8>(lds, z, mt, g); else pool_build<16>(lds, z, mt, g);
    asm volatile("s_waitcnt vmcnt(0)" ::: "memory");
    __syncthreads();
#pragma unroll
    for (int st = 0; st < 2; ++st) {
        LAS unsigned char* sb = lds + st * 49152;
#pragma unroll
        for (int ks = 0; ks < 2; ++ks) {
            const unsigned xk = ks ? xk1 : xk0;
            bf16x8 af[4], bfr[4];
#pragma unroll
            for (int m = 0; m < 4; ++m) af[m] = *(LAS bf16x8*)(sb + ard + m * 2048 + xk);
#pragma unroll
            for (int n = 0; n < 4; ++n) bfr[n] = *(LAS bf16x8*)(sb + brd + n * 2048 + xk);
#pragma unroll
            for (int m = 0; m < 4; ++m)
#pragma unroll
                for (int n = 0; n < 4; ++n) acc[m][n] = mfma16(bfr[n], af[m], acc[m][n]);
        }
    }
    __syncthreads();
}
DI void zero_acc(f32x4 (&acc)[4][4]) {
#pragma unroll
    for (int m = 0; m < 4; ++m)
#pragma unroll
        for (int n = 0; n < 4; ++n) acc[m][n] = (f32x4){0.f, 0.f, 0.f, 0.f};
}

DI void transpose_load(f32x4 (&v)[8], const float* src, int ldn, int k0, int n0) {
    const int tid = threadIdx.x, lk = tid >> 6, ln4 = (tid & 63) * 4;
#pragma unroll
    for (int i = 0; i < 8; ++i) v[i] = *(const f32x4*)(src + (size_t)(k0 + lk + 8 * i) * ldn + n0 + ln4);
}
DI void transpose_finish(const f32x4 (&v)[8], int K, bf16_t* dst, int k0, int n0, const float* gk, int mode, LAS float* t) {
    const int tid = threadIdx.x;
    const int lk = tid >> 6, ln4 = (tid & 63) * 4;
#pragma unroll
    for (int i = 0; i < 8; ++i) { LAS float* p = t + (lk + 8 * i) * 257 + ln4; p[0] = v[i].x; p[1] = v[i].y; p[2] = v[i].z; p[3] = v[i].w; }
    __syncthreads();
    const int c = tid & 7, nn = tid >> 3;
    float g[8];
#pragma unroll
    for (int j = 0; j < 8; ++j) g[j] = gk ? gk[k0 + c * 8 + j] : 1.0f;
#pragma unroll
    for (int i = 0; i < 4; ++i) {
        const int n = nn + 64 * i;
        float e[8];
#pragma unroll
        for (int j = 0; j < 8; ++j) e[j] = t[(c * 8 + j) * 257 + n] * g[j];
        const int f = n0 + n;
        const int drow = (mode == 0) ? f : ((f >> 7) * 256 + (mode == 2 ? 128 : 0) + (f & 127));
        const u32x4 o = {pk2(e[0], e[1]), pk2(e[2], e[3]), pk2(e[4], e[5]), pk2(e[6], e[7])};
        *(u32x4*)(dst + (size_t)drow * K + k0 + c * 8) = o;
    }
    __syncthreads();
}
DI void transpose_tile(const float* src, int ldn, int K, bf16_t* dst, int k0, int n0, const float* gk, int mode, LAS float* t) {
    f32x4 v[8];
    transpose_load(v, src, ldn, k0, n0);
    transpose_finish(v, K, dst, k0, n0, gk, mode, t);
}

DI void attn_stage_kv(LAS unsigned char* buf, const bf16_t* z, int tok0, int hd) {
    const int tid = threadIdx.x, lane = tid & 63, wave = __builtin_amdgcn_readfirstlane(tid >> 6);
    const int kchunk = (lane & 7) ^ ((((wave & 1) << 2) + (lane >> 4)) & 7);
    const int vchunk = (lane & 7) ^ (((lane >> 4) & 1) << 2);
#pragma unroll
    for (int i = 0; i < 4; ++i) {
        const bf16_t* rowp = z + (size_t)(tok0 + wave * 8 + (lane >> 3) + 64 * i) * ZLD + hd * 64;
        __builtin_amdgcn_global_load_lds((const unsigned*)(rowp + 512 + kchunk * 8), (LAS unsigned*)(buf + (wave * 8 + 64 * i) * 128), 16, 0, 0);
        __builtin_amdgcn_global_load_lds((const unsigned*)(rowp + 1024 + vchunk * 8), (LAS unsigned*)(buf + 32768 + (wave * 8 + 64 * i) * 128), 16, 0, 0);
    }
}
DI int crow(int i, int h) { return (i & 3) + 8 * (i >> 2) + 4 * h; }

template <int OFF>
DI void tr_read8(s16x4 (&r)[8], unsigned a0, unsigned a1) {
    asm volatile("ds_read_b64_tr_b16 %0, %8 offset:%c10\n\tds_read_b64_tr_b16 %1, %8 offset:%c11\n\tds_read_b64_tr_b16 %2, %8 offset:%c12\n\tds_read_b64_tr_b16 %3, %8 offset:%c13\n\t"
                 "ds_read_b64_tr_b16 %4, %9 offset:%c10\n\tds_read_b64_tr_b16 %5, %9 offset:%c11\n\tds_read_b64_tr_b16 %6, %9 offset:%c12\n\tds_read_b64_tr_b16 %7, %9 offset:%c13\n\t"
                 "s_waitcnt lgkmcnt(0)"
                 : "=&v"(r[0]), "=&v"(r[1]), "=&v"(r[2]), "=&v"(r[3]), "=&v"(r[4]), "=&v"(r[5]), "=&v"(r[6]), "=&v"(r[7])
                 : "v"(a0), "v"(a1), "i"(OFF), "i"(OFF + 1024), "i"(OFF + 2048), "i"(OFF + 3072) : "memory");
}
#ifndef ATTN_STUB
#define ATTN_STUB 0
#endif
template <int STUB>
DI void attn_block(LAS unsigned char* lds, const bf16x8 (&qf)[4], int dbase, int dlo, int ktmax, const LAS float* tb,
                   float& m_out, float& l_out, f32x16 (&o)[2]) {
    const int lane = threadIdx.x & 63, r31 = lane & 31, hh = lane >> 5;
    const int tq = (lane & 15) >> 2, tp = lane & 3, tblk = (lane >> 4) & 1;
    const unsigned kxor = (unsigned)((r31 >> 1) & 7);
    const unsigned vxr = (unsigned)(((tq >> 1) & 1) << 6);
    const unsigned vb0 = 32768u + (unsigned)(4 * hh + tq) * 128u + (vxr + 32u * tblk + 8u * tp);
    const unsigned vb1 = 32768u + (unsigned)(4 * hh + tq) * 128u + ((64u ^ vxr) + 32u * tblk + 8u * tp);
    const float C1 = 0.125f * LOG2E;
    float m = -INFINITY, l = 0.f;
    if (STUB == 2) { m_out = 0.f; l_out = 1.f;
#pragma unroll
        for (int i = 0; i < 16; ++i) { o[0][i] = qf[0][0]; o[1][i] = qf[1][0]; }
        return; }
    const float cfar = tb[128];
#pragma unroll
    for (int i = 0; i < 16; ++i) { o[0][i] = 0.f; o[1][i] = 0.f; }
#pragma unroll 1
    for (int half = 0; half < 2; ++half) {
        if (half * 4 > ktmax) break;
        f32x16 xs[4];
        float mx = m;
#pragma unroll
        for (int k4 = 0; k4 < 4; ++k4) {
            const int kt = half * 4 + k4;
            if (kt <= ktmax) {
#pragma unroll
                for (int i = 0; i < 16; ++i) xs[k4][i] = 0.f;
#pragma unroll
                for (int s = 0; s < 4; ++s) {
                    const bf16x8 kf = *(LAS bf16x8*)(lds + (kt * 32 + r31) * 128 + ((((unsigned)(2 * s + hh)) ^ kxor) << 4));
                    xs[k4] = mfma32(kf, qf[s], xs[k4]);
                }
                if (STUB == 0 && dlo - (kt * 32 + 31) < 128) {
#pragma unroll
                    for (int i = 0; i < 16; ++i) {
                        int dist = dbase - (kt * 32 + crow(i, hh));
                        const bool masked = dist < 0;
                        dist = dist > 128 ? 128 : (dist < 0 ? 0 : dist);
                        float tv = xs[k4][i] * C1 + tb[dist];
                        tv = masked ? -INFINITY : tv;
                        xs[k4][i] = tv; mx = fmaxf(mx, tv);
                    }
                } else {
#pragma unroll
                    for (int i = 0; i < 16; ++i) { const float tv = xs[k4][i] * C1 + cfar; xs[k4][i] = tv; mx = fmaxf(mx, tv); }
                }
            } else {
#pragma unroll
                for (int i = 0; i < 16; ++i) xs[k4][i] = -INFINITY;
            }
        }
        mx = fmaxf(mx, __shfl_xor(mx, 32));
        const float alpha = fast_exp2(m - mx);
        m = mx;
        float ls = 0.f;
#pragma unroll
        for (int k4 = 0; k4 < 4; ++k4)
#pragma unroll
            for (int i = 0; i < 16; ++i) { const float pv = STUB ? (xs[k4][i] - mx) : fast_exp2(xs[k4][i] - mx); xs[k4][i] = pv; ls += pv; }
        l = l * alpha + ls;
#pragma unroll
        for (int i = 0; i < 16; ++i) { o[0][i] *= alpha; o[1][i] *= alpha; }
        const unsigned va0 = (unsigned)(size_t)lds + vb0 + (unsigned)half * 16384u, va1 = (unsigned)(size_t)lds + vb1 + (unsigned)half * 16384u;
#pragma unroll
        for (int k4 = 0; k4 < 4; ++k4) {
            const int kt = half * 4 + k4;
            if (kt <= ktmax) {
                s16x4 vr[8];
                if (k4 == 0) tr_read8<0>(vr, va0, va1); else if (k4 == 1) tr_read8<4096>(vr, va0, va1); else if (k4 == 2) tr_read8<8192>(vr, va0, va1); else tr_read8<12288>(vr, va0, va1);
#pragma unroll
                for (int sp = 0; sp < 2; ++sp) {
                    const u32x4 pw = {pk2(xs[k4][8 * sp + 0], xs[k4][8 * sp + 1]), pk2(xs[k4][8 * sp + 2], xs[k4][8 * sp + 3]),
                                      pk2(xs[k4][8 * sp + 4], xs[k4][8 * sp + 5]), pk2(xs[k4][8 * sp + 6], xs[k4][8 * sp + 7])};
                    const bf16x8 pf = __builtin_bit_cast(bf16x8, pw);
                    const bf16x8 vf0 = __builtin_shufflevector(vr[2 * sp], vr[2 * sp + 1], 0, 1, 2, 3, 4, 5, 6, 7);
                    const bf16x8 vf1 = __builtin_shufflevector(vr[4 + 2 * sp], vr[4 + 2 * sp + 1], 0, 1, 2, 3, 4, 5, 6, 7);
                    o[0] = mfma32(vf0, pf, o[0]);
                    o[1] = mfma32(vf1, pf, o[1]);
                }
            }
        }
    }
    l += __shfl_xor(l, 32);
    m_out = m; l_out = l;
}

DI int xcd_remap(int L, int nwg) { const int q = nwg / 8, r = nwg % 8, xcd = L % 8, off = L / 8; return (xcd < r ? xcd * (q + 1) : r * (q + 1) + (xcd - r) * q) + off; }
struct SchedDense {
    int nM, nN, G, c, K; const unsigned char* Bt;
    DI bool next(int i, GUnit& u) const {
        const int nwg = nM * nN; const int L = i * G + c; if (L >= nwg) return false;
        const int wgid = xcd_remap(L, nwg);
        const int nig = 8 * nN, gid = wgid / nig, fm = gid * 8, gsz = (nM - fm) < 8 ? (nM - fm) : 8;
        u.pm = fm + ((wgid % nig) % gsz); u.pn = (wgid % nig) / gsz; u.e = 0; u.cnt = 0;
        u.bptr = Bt + (size_t)u.pn * 256 * K * 2; return true;
    }
    DI void aoffs(const GUnit& u, const int (&R)[2], const int (&C)[2], unsigned (&o)[2][2]) const {
#pragma unroll
        for (int h = 0; h < 2; ++h)
#pragma unroll
            for (int i = 0; i < 2; ++i) o[h][i] = (unsigned)((u.pm * 256 + 128 * h + R[i]) * K + C[i]) * 2u;
    }
};
struct SchedLight {
    int nM, nN, K, first, stride; bool active; const unsigned char* Bt;
    DI bool next(int i, GUnit& u) const {
        const int L = first + i * stride; if (!active || L >= nM * nN) return false;
        u.pm = L / nN; u.pn = L % nN; u.e = 0; u.cnt = 0; u.bptr = Bt + (size_t)u.pn * 256 * K * 2; return true;
    }
    DI void aoffs(const GUnit& u, const int (&R)[2], const int (&C)[2], unsigned (&o)[2][2]) const {
#pragma unroll
        for (int h = 0; h < 2; ++h)
#pragma unroll
            for (int i = 0; i < 2; ++i) o[h][i] = (unsigned)((u.pm * 256 + 128 * h + R[i]) * K + C[i]) * 2u;
    }
};
struct SchedMoe {
    const LAS int* ecnt; const LAS int* epre; const LAS int* ehoff; int G, c, K; const unsigned char* Bt; size_t bstride;
    const unsigned* tok_list; int mode;
    DI bool next(int i, GUnit& u) const {
        const int nwg = epre[32]; const int L = i * G + c; if (L >= nwg) return false;
        const int wgid = xcd_remap(L, nwg);
        int e = 0;
        while (epre[e + 1] <= wgid) ++e;
        const int loc = wgid - epre[e];
        u.e = e; u.cnt = ecnt[e]; u.pm = loc >> 2; u.pn = loc & 3;
        u.bptr = Bt + (size_t)e * bstride + (size_t)u.pn * 256 * K * 2; return true;
    }
    DI void aoffs(const GUnit& u, const int (&R)[2], const int (&C)[2], unsigned (&o)[2][2]) const {
#pragma unroll
        for (int h = 0; h < 2; ++h)
#pragma unroll
            for (int i = 0; i < 2; ++i) {
                int r = u.pm * 256 + 128 * h + R[i]; r = r < u.cnt ? r : u.cnt - 1;
                const unsigned row = mode == 0 ? (tok_list[u.e * 16384 + r] & 0x3FFFu) : (unsigned)(ehoff[u.e] + r);
                o[h][i] = (row * (unsigned)K + (unsigned)C[i]) * 2u;
            }
    }
};
#define EPI_LOOP_BEGIN \
    _Pragma("unroll") for (int ai = 0; ai < 2; ++ai) _Pragma("unroll") for (int m = 0; m < 4; ++m) { const int rl = 128 * ai + 64 * wr + 16 * m + fr;
#define EPI_LOOP_END }
struct EpiZ {
    bf16_t* z; const float* rstd0; float* kmean; LAS float* red;
    DI void operator()(const f32x4 (&acc)[2][2][4][2], const GUnit& u, int wr, int wc, int fr, int fq) const {
        f32x4 cs[2][2];
#pragma unroll
        for (int bj = 0; bj < 2; ++bj)
#pragma unroll
            for (int n = 0; n < 2; ++n) cs[bj][n] = (f32x4){0.f, 0.f, 0.f, 0.f};
        EPI_LOOP_BEGIN
            const int row = u.pm * 256 + rl; const float rs = rstd0[row];
#pragma unroll
            for (int bj = 0; bj < 2; ++bj)
#pragma unroll
                for (int n = 0; n < 2; ++n) { const int col = u.pn * 256 + 128 * bj + 32 * wc + 8 * fq + 4 * n; const f32x4 v = acc[ai][bj][m][n] * rs;
                    cs[bj][n] += v;
                    *(u32x2*)(z + (size_t)row * ZLD + col) = (u32x2){pk2(v.x, v.y), pk2(v.z, v.w)}; }
        EPI_LOOP_END
        if (u.pn == 2 || u.pn == 3) {
#pragma unroll
            for (int bj = 0; bj < 2; ++bj)
#pragma unroll
                for (int n = 0; n < 2; ++n)
#pragma unroll
                    for (int q = 0; q < 4; ++q) { float v = cs[bj][n][q]; v += __shfl_xor(v, 1); v += __shfl_xor(v, 2); v += __shfl_xor(v, 4); v += __shfl_xor(v, 8);
                        if (fr == 0) red[wr * 256 + 128 * bj + 32 * wc + 8 * fq + 4 * n + q] = v; }
            asm volatile("s_waitcnt lgkmcnt(0)" ::: "memory"); __builtin_amdgcn_s_barrier(); asm volatile("" ::: "memory");
            const int t = threadIdx.x;
            if (t < 256) { const float sm = red[t] + red[256 + t]; const int col = u.pn * 256 + t - 512;
                kmean[(((u.pm >> 5) * 8 + (col >> 6)) * 32 + (u.pm & 31)) * 64 + (col & 63)] = sm * (1.0f / 256.0f); }
            asm volatile("s_waitcnt lgkmcnt(0)" ::: "memory"); __builtin_amdgcn_s_barrier(); asm volatile("" ::: "memory");
        }
    }
};
struct EpiBf16Plain {
    bf16_t* o; int ld;
    DI void operator()(const f32x4 (&acc)[2][2][4][2], const GUnit& u, int wr, int wc, int fr, int fq) const {
        EPI_LOOP_BEGIN
            const int row = u.pm * 256 + rl;
#pragma unroll
            for (int bj = 0; bj < 2; ++bj)
#pragma unroll
                for (int n = 0; n < 2; ++n) { const int col = u.pn * 256 + 128 * bj + 32 * wc + 8 * fq + 4 * n; const f32x4 v = acc[ai][bj][m][n];
                    *(u32x2*)(o + (size_t)row * ld + col) = (u32x2){pk2(v.x, v.y), pk2(v.z, v.w)}; }
        EPI_LOOP_END
    }
};
struct EpiX1 {
    bf16_t* xb; float* ss; bool dry;
    DI void operator()(const f32x4 (&acc)[2][2][4][2], const GUnit& u, int wr, int wc, int fr, int fq) const {
        EPI_LOOP_BEGIN
            const int row = u.pm * 256 + rl; float sq = 0.f;
#pragma unroll
            for (int bj = 0; bj < 2; ++bj) { const int col = u.pn * 256 + 128 * bj + 32 * wc + 8 * fq;
                u32x4* px = (u32x4*)(xb + (size_t)row * D + col);
                const u32x4 xw = *px;
                const f32x4 v0 = (f32x4){bflo(xw.x), bfhi(xw.x), bflo(xw.y), bfhi(xw.y)} + acc[ai][bj][m][0];
                const f32x4 v1 = (f32x4){bflo(xw.z), bfhi(xw.z), bflo(xw.w), bfhi(xw.w)} + acc[ai][bj][m][1];
                if (!dry) *px = (u32x4){pk2(v0.x, v0.y), pk2(v0.z, v0.w), pk2(v1.x, v1.y), pk2(v1.z, v1.w)};
                sq += ((v0.x * v0.x + v0.y * v0.y) + (v0.z * v0.z + v0.w * v0.w)) + ((v1.x * v1.x + v1.y * v1.y) + (v1.z * v1.z + v1.w * v1.w)); }
            sq += __shfl_xor(sq, 16); sq += __shfl_xor(sq, 32);
            if (fq == 0 && !dry) ss[row * 16 + u.pn * 4 + wc] = sq;
        EPI_LOOP_END
    }
};
struct EpiHid {
    bf16_t* hid; const unsigned* tok_list; const float* gate_list; const float* rstd1; const LAS int* ehoff;
    DI void operator()(const f32x4 (&acc)[2][2][4][2], const GUnit& u, int wr, int wc, int fr, int fq) const {
        EPI_LOOP_BEGIN
            const int r = u.pm * 256 + rl;
            if (r < u.cnt) {
                const unsigned tok = tok_list[u.e * 16384 + r] & 0x3FFFu;
                const float gw = gate_list[u.e * 16384 + r];
                const float rs = rstd1[tok];
                bf16_t* hp = hid + (size_t)(ehoff[u.e] + r) * 512 + u.pn * 128 + 32 * wc + 8 * fq;
                float h8[8];
#pragma unroll
                for (int n = 0; n < 2; ++n) {
                    const f32x4 a = acc[ai][0][m][n] * rs, uu = acc[ai][1][m][n] * rs;
#pragma unroll
                    for (int q = 0; q < 4; ++q) { const float sg = a[q] * fast_rcp(1.0f + __expf(-a[q])); h8[4 * n + q] = sg * uu[q] * gw; }
                }
                *(u32x4*)hp = (u32x4){pk2(h8[0], h8[1]), pk2(h8[2], h8[3]), pk2(h8[4], h8[5]), pk2(h8[6], h8[7])};
            }
        EPI_LOOP_END
    }
};
struct EpiY {
    bf16_t* yslot; const unsigned* tok_list;
    DI void operator()(const f32x4 (&acc)[2][2][4][2], const GUnit& u, int wr, int wc, int fr, int fq) const {
        EPI_LOOP_BEGIN
            const int r = u.pm * 256 + rl;
            if (r < u.cnt) {
                const unsigned ent = tok_list[u.e * 16384 + r]; const unsigned tok = ent & 0x3FFFu, slot = ent >> 14;
                bf16_t* yp = yslot + ((size_t)slot * T + tok) * D;
#pragma unroll
                for (int bj = 0; bj < 2; ++bj)
#pragma unroll
                    for (int n = 0; n < 2; ++n) { const int col = u.pn * 256 + 128 * bj + 32 * wc + 8 * fq + 4 * n; const f32x4 v = acc[ai][bj][m][n];
                        *(u32x2*)(yp + col) = (u32x2){pk2(v.x, v.y), pk2(v.z, v.w)}; }
            }
        EPI_LOOP_END
    }
};
struct EpiX3F {
    const bf16_t* x2; float* out; const bf16_t* pp; const float* rstd2; float* ss; unsigned* pcnt; const float* gfin;
    DI void operator()(f32x4 (&acc)[2][2][4][2], const GUnit& u, int wr, int wc, int fr, int fq) const {
        EPI_LOOP_BEGIN
            const int row = u.pm * 256 + rl; const float rs = rstd2[row]; float sq = 0.f;
#pragma unroll
            for (int bj = 0; bj < 2; ++bj) { const int col = u.pn * 256 + 128 * bj + 32 * wc + 8 * fq;
                const u32x4 xw = *(const u32x4*)(x2 + (size_t)row * D + col);
                const u32x4 pw = *(const u32x4*)(pp + (size_t)row * D + col);
                const float xv[8] = {bflo(xw.x), bfhi(xw.x), bflo(xw.y), bfhi(xw.y), bflo(xw.z), bfhi(xw.z), bflo(xw.w), bfhi(xw.w)};
                const float pv[8] = {bflo(pw.x), bfhi(pw.x), bflo(pw.y), bfhi(pw.y), bflo(pw.z), bfhi(pw.z), bflo(pw.w), bfhi(pw.w)};
#pragma unroll
                for (int n = 0; n < 2; ++n) { f32x4 v;
#pragma unroll
                    for (int q = 0; q < 4; ++q) { const float gt = fast_rcp(1.0f + __expf(-acc[ai][bj][m][n][q] * rs)); v[q] = xv[4 * n + q] + pv[4 * n + q] * gt; }
                    acc[ai][bj][m][n] = v;
                    sq += (v.x * v.x + v.y * v.y) + (v.z * v.z + v.w * v.w); } }
            sq += __shfl_xor(sq, 16); sq += __shfl_xor(sq, 32);
            if (fq == 0) atomicAdd(&ss[row], sq);
        EPI_LOOP_END
        asm volatile("s_waitcnt vmcnt(0)" ::: "memory");
        unsigned* pc = pcnt + 64 * u.pm;
        if ((threadIdx.x & 63) == 0) __hip_atomic_fetch_add(pc, 1u, __ATOMIC_RELAXED, __HIP_MEMORY_SCOPE_AGENT);
        for (unsigned spins = 0; spins < (1u << 22); ++spins) {
            const unsigned c = (unsigned)__builtin_amdgcn_readfirstlane((int)__hip_atomic_load(pc, __ATOMIC_RELAXED, __HIP_MEMORY_SCOPE_AGENT));
            if (c >= 32u) break;
            __builtin_amdgcn_s_sleep(2);
        }
        EPI_LOOP_BEGIN
            const int row = u.pm * 256 + rl;
            const float r3 = rsqrtf(__hip_atomic_load(&ss[row], __ATOMIC_RELAXED, __HIP_MEMORY_SCOPE_AGENT) * (1.0f / D) + EPS);
#pragma unroll
            for (int bj = 0; bj < 2; ++bj)
#pragma unroll
                for (int n = 0; n < 2; ++n) { const int col = u.pn * 256 + 128 * bj + 32 * wc + 8 * fq + 4 * n;
                    const f32x4 g4 = *(const f32x4*)(gfin + col);
                    *(f32x4*)(out + (size_t)row * D + col) = acc[ai][bj][m][n] * r3 * g4; }
        EPI_LOOP_END
    }
};
struct EpiX3 {
    const bf16_t* x2; float* out; const bf16_t* pp; const float* rstd2; float* ss; bool dry;
    DI void operator()(const f32x4 (&acc)[2][2][4][2], const GUnit& u, int wr, int wc, int fr, int fq) const {
        EPI_LOOP_BEGIN
            const int row = u.pm * 256 + rl; const float rs = rstd2[row]; float sq = 0.f;
#pragma unroll
            for (int bj = 0; bj < 2; ++bj)
#pragma unroll
                for (int n = 0; n < 2; ++n) { const int col = u.pn * 256 + 128 * bj + 32 * wc + 8 * fq + 4 * n;
                    const u32x2 xw = *(const u32x2*)(x2 + (size_t)row * D + col);
                    f32x4 v = {bflo(xw.x), bfhi(xw.x), bflo(xw.y), bfhi(xw.y)};
                    const u32x2 pw = *(const u32x2*)(pp + (size_t)row * D + col);
                    const float p4[4] = {bflo(pw.x), bfhi(pw.x), bflo(pw.y), bfhi(pw.y)};
#pragma unroll
                    for (int q = 0; q < 4; ++q) { const float gt = fast_rcp(1.0f + __expf(-acc[ai][bj][m][n][q] * rs)); v[q] += p4[q] * gt; }
                    if (!dry) *(f32x4*)(out + (size_t)row * D + col) = v;
                    sq += (v.x * v.x + v.y * v.y) + (v.z * v.z + v.w * v.w); }
            sq += __shfl_xor(sq, 16); sq += __shfl_xor(sq, 32);
            if (fq == 0 && !dry) atomicAdd(&ss[row], sq);
        EPI_LOOP_END
    }
};

DI const void* karg_ptr(int byte_off) {
    unsigned long long p;
    asm volatile("s_load_dwordx2 %0, %1, %2\n\ts_waitcnt lgkmcnt(0)" : "=s"(p) : "s"(__builtin_amdgcn_kernarg_segment_ptr()), "i"(byte_off) : "memory");
    return (const void*)(const __attribute__((address_space(1))) void*)p;
}
struct Params {
    const float* in[20];
    float* out;
    unsigned char* ws;
    int dry, pad;
};

template <unsigned MASK, bool HASDRY>
__global__ void __launch_bounds__(NT, 2) hymba_fwd(Params P) {
    extern __shared__ __attribute__((aligned(16))) unsigned char smem_raw[];
    LAS unsigned char* lds = (LAS unsigned char*)smem_raw;
    const int tid = threadIdx.x, lane = tid & 63;
    const int wave = __builtin_amdgcn_readfirstlane(tid >> 6);
    const int G = gridDim.x;
    const int vcu = (G % 8 == 0) ? ((int)(blockIdx.x % 8) * (G / 8) + (int)(blockIdx.x / 8)) : (int)blockIdx.x;
    unsigned char* ws = (unsigned char*)karg_ptr(168);

    volatile LAS unsigned* misc = (volatile LAS unsigned*)(lds + LDS_MISC);
    if (tid < 4) misc[tid] = 0u;
    __syncthreads();
    const bool dry = HASDRY ? (P.dry != 0) : false; (void)dry;
    XcdBarrier bar; bar.bar = (unsigned*)(ws + WS_CTL); bar.x = 0; bar.st = misc;
    if (!HASDRY) bar = xcd_barrier_post((unsigned*)(ws + WS_CTL), misc);
    LAS int* marr = (LAS int*)(lds + LDS_MISC + MISC_ARR);

    const float* x;
    const float* pin;
    const float* g_mix;
    const float* w_in;
    const float* w_pool;
    const float* pool_scale;
    const float* w_out;
    const float* rel_bias;
    const float* g_ffn;
    const float* w_r1;
    const float* b_r1;
    const float* w_r2;
    const float* b_r2;
    const float* w_gate;
    const float* w_up;
    const float* w_down;
    const float* g_ple;
    const float* w_ple;
    const float* w_pg;
    const float* g_final;
    float* out;
    unsigned* cnt_sel;
    unsigned* cnt_exp;
    float* ss1;
    float* ss3;
    float* kmean;
    float* tab;
    float* rstd0;
    float* rstd2;
    float* routeb;
    bf16_t* WinT;
    bf16_t* WoutT;
    bf16_t* WpgT;
    bf16_t* WpleT;
    bf16_t* WpoolT;
    bf16_t* WrT;
    bf16_t* xb;
    bf16_t* z;
    bf16_t* WguT;
    bf16_t* yslot;
    unsigned* tok_list;
    float* gate_list;
    unsigned* sel_list;
    bf16_t* part_o;
    bf16_t* WdT;
    float* part_ml;
    bf16_t* ab;
    bf16_t* hid;
    bf16_t* pb;
    bf16_t* ppb;
    {
        unsigned char* wsl = (unsigned char*)karg_ptr(168);
        x = (const float*)karg_ptr(8 * 0);
        pin = (const float*)karg_ptr(8 * 1);
        g_mix = (const float*)karg_ptr(8 * 2);
        w_in = (const float*)karg_ptr(8 * 3);
        w_pool = (const float*)karg_ptr(8 * 4);
        pool_scale = (const float*)karg_ptr(8 * 5);
        w_out = (const float*)karg_ptr(8 * 6);
        rel_bias = (const float*)karg_ptr(8 * 7);
        w_r1 = (const float*)karg_ptr(8 * 9);
        b_r1 = (const float*)karg_ptr(8 * 10);
        w_r2 = (const float*)karg_ptr(8 * 11);
        b_r2 = (const float*)karg_ptr(8 * 12);
        g_ple = (const float*)karg_ptr(8 * 16);
        w_ple = (const float*)karg_ptr(8 * 17);
        w_pg = (const float*)karg_ptr(8 * 18);
        tab = (float*)(wsl + WS_TAB);
        rstd0 = (float*)(wsl + WS_RSTD0);
        routeb = (float*)(wsl + WS_RB);
        WinT = (bf16_t*)(wsl + WS_WIN);
        WoutT = (bf16_t*)(wsl + WS_WOUT);
        WpgT = (bf16_t*)(wsl + WS_WPG);
        WpleT = (bf16_t*)(wsl + WS_WPLE);
        WpoolT = (bf16_t*)(wsl + WS_WPOOL);
        WrT = (bf16_t*)(wsl + WS_WR);
        xb = (bf16_t*)(wsl + WS_XB);
        z = (bf16_t*)(wsl + WS_Z);
        pb = (bf16_t*)(wsl + WS_PB);
        g_ffn = (const float*)karg_ptr(8 * 8);
    }

    const int srow = tid >> 3, sc = (tid & 7) ^ (srow & 7);
    const int wm = wave >> 1, wn = wave & 1, fr = lane & 15, fq = lane >> 4;
    const int r31 = lane & 31, hh = lane >> 5;

    if constexpr (PH(0)) {
    {
        for (int i = vcu * NT + tid; i < 65536 + 49152 + 1056 + 48; i += G * NT) {
            if (i < 65536) {
                const int g = i >> 14, n = (i >> 7) & 127, k = i & 127;
                WpoolT[i] = (bf16_t)(pk2(w_pool[(g * 128 + k) * 128 + n] * pool_scale[g * 128 + n], 0.f) & 0xffffu);
            } else if (i < 65536 + 49152) {
                const int j = i - 65536, n = j >> 10, k = j & 1023;
                float v = 0.f;
                if (n < 4) v = w_r1[k * 4 + n] * g_ffn[k];
                else if (n < 36) { const int gg = (n - 4) >> 3, e = (n - 4) & 7; v = w_r2[(gg * 1024 + k) * 8 + e] * g_ffn[k]; }
                WrT[j] = (bf16_t)(pk2(v, 0.f) & 0xffffu);
            } else if (i < 65536 + 49152 + 1056) {
                const int j = i - 65536 - 49152, h = j / 132, d = j % 132;
                int bk;
                if (d < 16) bk = d;
                else { bk = 16 + (int)(logf((float)d / 16.0f) / logf(8.0f) * 16.0f); bk = bk > 31 ? 31 : bk; }
                tab[j] = rel_bias[bk * 8 + h] * LOG2E;
            } else {
                const int j = i - 65536 - 49152 - 1056;
                routeb[j] = j < 4 ? b_r1[j] : (j < 36 ? b_r2[j - 4] : 0.f);
            }
        }
        LAS float* tl = (LAS float*)lds;
        for (int it = vcu; it < 272; it += G) {
            int r = it;
            if (r < 128) { transpose_tile(w_in, 2048, 1024, WinT, (r >> 3) * 64, (r & 7) * 256, g_mix, 0, tl); continue; } r -= 128;
            if (r < 64)  { transpose_tile(w_out, 1024, 1024, WoutT, (r >> 2) * 64, (r & 3) * 256, nullptr, 0, tl); continue; } r -= 64;
            if (r < 64)  { transpose_tile(w_pg, 1024, 1024, WpgT, (r >> 2) * 64, (r & 3) * 256, g_ple, 0, tl); continue; } r -= 64;
            transpose_tile(w_ple, 1024, 256, WpleT, (r >> 2) * 64, (r & 3) * 256, nullptr, 0, tl);
        }
        for (int i = vcu * NT + tid; i < T * 256 / 8; i += G * NT) {
            const f32x4 v0 = ((const f32x4*)pin)[2 * i], v1 = ((const f32x4*)pin)[2 * i + 1];
            ((u32x4*)pb)[i] = (u32x4){pk2(v0.x, v0.y), pk2(v0.z, v0.w), pk2(v1.x, v1.y), pk2(v1.z, v1.w)};
        }
        for (int row = (vcu * 8 + wave) * 2; row < T; row += G * 16) {
            const f32x4* xr = (const f32x4*)(x + (size_t)row * D) + lane;
            f32x4 v[8]; float s0 = 0.f, s1 = 0.f;
#pragma unroll
            for (int j = 0; j < 8; ++j) v[j] = xr[64 * j];
#pragma unroll
            for (int j = 0; j < 4; ++j) { s0 += (v[j].x * v[j].x + v[j].y * v[j].y) + (v[j].z * v[j].z + v[j].w * v[j].w);
                                          s1 += (v[4 + j].x * v[4 + j].x + v[4 + j].y * v[4 + j].y) + (v[4 + j].z * v[4 + j].z + v[4 + j].w * v[4 + j].w); }
            s0 = wave_sum(s0); s1 = wave_sum(s1);
            u32x2* o = (u32x2*)(xb + (size_t)row * D) + lane;
#pragma unroll
            for (int j = 0; j < 8; ++j) o[64 * j] = (u32x2){pk2(v[j].x, v[j].y), pk2(v[j].z, v[j].w)};
            if (lane == 0) { rstd0[row] = rsqrtf(s0 * (1.0f / D) + EPS); rstd0[row + 1] = rsqrtf(s1 * (1.0f / D) + EPS); }
        }
    }
    }
    if constexpr (!HASDRY) xcd_barrier(bar);
    {
        unsigned char* wsl = (unsigned char*)karg_ptr(168);
        x = (const float*)karg_ptr(8 * 0);
        rstd0 = (float*)(wsl + WS_RSTD0);
        WinT = (bf16_t*)(wsl + WS_WIN);
        xb = (bf16_t*)(wsl + WS_XB);
        z = (bf16_t*)(wsl + WS_Z);
        kmean = (float*)(wsl + WS_KMEAN);
    }

    if constexpr (PH(1)) {
    {
        SchedDense S1{64, 8, G, (int)blockIdx.x, 1024, (const unsigned char*)WinT};
        gemm8(lds, (const unsigned char*)xb, 1024, S1, EpiZ{z, rstd0, kmean, (LAS float*)(lds + LDS_MISC + 10240)});
    }
    }
    if constexpr (!HASDRY) xcd_barrier(bar);
    {
        unsigned char* wsl = (unsigned char*)karg_ptr(168);
        x = (const float*)karg_ptr(8 * 0);
        kmean = (float*)(wsl + WS_KMEAN);
        WpleT = (bf16_t*)(wsl + WS_WPLE);
        z = (bf16_t*)(wsl + WS_Z);
        pb = (bf16_t*)(wsl + WS_PB);
        ppb = (bf16_t*)(wsl + WS_PP);
    }

    {
        unsigned char* wsl = (unsigned char*)karg_ptr(168);
        x = (const float*)karg_ptr(8 * 0);
        cnt_sel = (unsigned*)(wsl + OFF_CNT_SEL);
        kmean = (float*)(wsl + WS_KMEAN);
        WpoolT = (bf16_t*)(wsl + WS_WPOOL);
        z = (bf16_t*)(wsl + WS_Z);
        sel_list = (unsigned*)(wsl + WS_SEL);
        ab = (bf16_t*)(wsl + WS_AB);
    }

    if constexpr (PH(3)) {
    {
        LAS unsigned char* kmh = lds;
        LAS unsigned char* kml = lds + 4096;
        LAS unsigned* hist = (LAS unsigned*)marr;
        for (int u = vcu; u < 256; u += G) {
            const int bh = u >> 4, ck = u & 15, b = bh >> 3, hd = bh & 7;
            const int s = ck * 512 + tid, ob = s >> 8;
            __syncthreads();
            {
                const int j = tid >> 4, d0 = (tid & 15) * 4;
                const f32x4 kv = *(const f32x4*)(kmean + (size_t)bh * 2048 + tid * 4);
                const unsigned h0 = pk2(kv.x, kv.y), h1 = pk2(kv.z, kv.w);
                const unsigned l0 = pk2(kv.x - bflo(h0), kv.y - bfhi(h0)), l1 = pk2(kv.z - bflo(h1), kv.w - bfhi(h1));
                const unsigned off = (unsigned)j * 128u + ((((unsigned)(d0 >> 3)) ^ (((unsigned)j >> 1) & 7u)) << 4) + (unsigned)(d0 & 7) * 2u;
                *(LAS u32x2*)(kmh + off) = (u32x2){h0, h1};
                *(LAS u32x2*)(kml + off) = (u32x2){l0, l1};
            }
            if (tid < 32) hist[tid] = 0u;
            bf16x8 qg[2][4];
#pragma unroll
            for (int t2 = 0; t2 < 2; ++t2) {
                const bf16_t* qp = z + (size_t)(b * SEQ + ck * 512 + wave * 64 + t2 * 32 + r31) * ZLD + hd * 64 + 8 * hh;
#pragma unroll
                for (int s2 = 0; s2 < 4; ++s2) qg[t2][s2] = *(const bf16x8*)(qp + 16 * s2);
            }
            __syncthreads();
            float v0 = -INFINITY, v1 = -INFINITY, v2 = -INFINITY; int i0 = 0, i1 = 0, i2 = 0;
#pragma unroll
            for (int t2 = 0; t2 < 2; ++t2) {
                f32x16 g16;
#pragma unroll
                for (int i = 0; i < 16; ++i) g16[i] = 0.f;
#pragma unroll
                for (int s2 = 0; s2 < 4; ++s2) {
                    const unsigned ko = (unsigned)r31 * 128u + ((((unsigned)(2 * s2 + hh)) ^ (((unsigned)r31 >> 1) & 7u)) << 4);
                    g16 = mfma32(*(LAS bf16x8*)(kmh + ko), qg[t2][s2], g16);
                    g16 = mfma32(*(LAS bf16x8*)(kml + ko), qg[t2][s2], g16);
                }
                float a0 = -INFINITY, a1 = -INFINITY, a2 = -INFINITY; int j0 = 64, j1 = 64, j2 = 64;
#pragma unroll
                for (int i = 0; i < 16; ++i) {
                    const int j = crow(i, hh); const float gv = (j < ob) ? g16[i] : -INFINITY;
                    if (gv > a2) {
                        if (gv > a1) { a2 = a1; j2 = j1; if (gv > a0) { a1 = a0; j1 = j0; a0 = gv; j0 = j; } else { a1 = gv; j1 = j; } }
                        else { a2 = gv; j2 = j; }
                    }
                }
                float pv[3] = {__shfl_xor(a0, 32), __shfl_xor(a1, 32), __shfl_xor(a2, 32)};
                int pj[3] = {__shfl_xor(j0, 32), __shfl_xor(j1, 32), __shfl_xor(j2, 32)};
#pragma unroll
                for (int k = 0; k < 3; ++k) {
                    const float gv = pv[k]; const int j = pj[k];
                    const bool b2 = gv > a2 || (gv == a2 && j < j2), b1 = gv > a1 || (gv == a1 && j < j1), b0 = gv > a0 || (gv == a0 && j < j0);
                    if (b2) {
                        if (b1) { a2 = a1; j2 = j1; if (b0) { a1 = a0; j1 = j0; a0 = gv; j0 = j; } else { a1 = gv; j1 = j; } }
                        else { a2 = gv; j2 = j; }
                    }
                }
                if (hh == t2) { v0 = a0; v1 = a1; v2 = a2; i0 = j0; i1 = j1; i2 = j2; }
            }
            i0 &= 31; i1 &= 31; i2 &= 31;
            const int nvalid = ob < 3 ? ob : 3;
            unsigned lp0 = 0, lp1 = 0, lp2 = 0;
            if (dry) { if (v0 + v1 + v2 == 12345.f) cnt_sel[0] = (unsigned)(i0 + i1 + i2); continue; }
            if (nvalid > 0) lp0 = atomicAdd((unsigned*)&hist[i0], 1u);
            if (nvalid > 1) lp1 = atomicAdd((unsigned*)&hist[i1], 1u);
            if (nvalid > 2) lp2 = atomicAdd((unsigned*)&hist[i2], 1u);
            __syncthreads();
            if (tid < 32) { const unsigned c = hist[tid]; hist[32 + tid] = c ? atomicAdd(&cnt_sel[bh * 32 + tid], c) : 0u; }
            __syncthreads();
            if (nvalid > 0) sel_list[(size_t)(bh * 32 + i0) * 8192 + hist[32 + i0] + lp0] = (unsigned)s | (0u << 13);
            if (nvalid > 1) sel_list[(size_t)(bh * 32 + i1) * 8192 + hist[32 + i1] + lp1] = (unsigned)s | (1u << 13);
            if (nvalid > 2) sel_list[(size_t)(bh * 32 + i2) * 8192 + hist[32 + i2] + lp2] = (unsigned)s | (2u << 13);
        }
        __syncthreads();
        for (int u = vcu; u < 256; u += G) {
            const int mt = u >> 2, g = u & 3;
            unsigned aoff[4], boff[2];
#pragma unroll
            for (int i = 0; i < 2; ++i) boff[i] = (unsigned)(((g * 128) + srow + 64 * i) * 128 + sc * 8) * 2u;
            f32x4 acc[4][4]; zero_acc(acc);
            pool_unit(acc, lds, z, mt, g, (const unsigned char*)WpoolT, boff);
#pragma unroll
            for (int m = 0; m < 4; ++m) {
                const int row = mt * 256 + wm * 64 + m * 16 + fr;
#pragma unroll
                for (int n = 0; n < 4; ++n) {
                    const int col = 512 + g * 128 + wn * 64 + n * 16 + fq * 4;
                    const f32x4 v = acc[m][n];
                    *(u32x2*)(ab + (size_t)row * D + col) = (u32x2){pk2(v.x, v.y), pk2(v.z, v.w)};
                }
            }
        }
    }
    }
    if constexpr (!HASDRY) xcd_barrier(bar);
    {
        unsigned char* wsl = (unsigned char*)karg_ptr(168);
        cnt_sel = (unsigned*)(wsl + OFF_CNT_SEL);
        tab = (float*)(wsl + WS_TAB);
        z = (bf16_t*)(wsl + WS_Z);
        sel_list = (unsigned*)(wsl + WS_SEL);
        part_o = (bf16_t*)(wsl + WS_PARTO);
        part_ml = (float*)(wsl + WS_PARTML);
    }

    if constexpr (PH(4)) {
    {
        LAS int* pre = marr;
        LAS float* tabl = (LAS float*)(lds + LDS_MISC + MISC_TAB);
        LAS int* desc = (LAS int*)(lds + LDS_MISC + MISC_DESC);
        __syncthreads();
        if (wave == 0) {
            const u32x4 c0 = *(const u32x4*)(cnt_sel + lane * 8), c1 = *(const u32x4*)(cnt_sel + lane * 8 + 4);
            int v[8] = {(int)((c0.x + 255u) >> 8), (int)((c0.y + 255u) >> 8), (int)((c0.z + 255u) >> 8), (int)((c0.w + 255u) >> 8),
                        (int)((c1.x + 255u) >> 8), (int)((c1.y + 255u) >> 8), (int)((c1.z + 255u) >> 8), (int)((c1.w + 255u) >> 8)};
#pragma unroll
            for (int i = 1; i < 8; ++i) v[i] += v[i - 1];
            int tot = v[7];
#pragma unroll
            for (int o2 = 1; o2 < 64; o2 <<= 1) { const int t2 = __shfl_up(tot, o2); if (lane >= o2) tot += t2; }
            const int base = tot - v[7];
            if (lane == 0) pre[0] = 0;
#pragma unroll
            for (int i = 0; i < 8; ++i) pre[lane * 8 + i + 1] = base + v[i];
        }
        __syncthreads();
        const int total = pre[512];
        for (int i = tid; i < 8 * 132; i += NT) { const int h = i / 132; tabl[i] = tab[i] - tab[h * 132 + 128]; }
        LAS float* c31l = (LAS float*)(lds + LDS_MISC + MISC_DESC + 1024);
        if (tid < 8) c31l[tid] = tab[tid * 132 + 128];
        const int nun = vcu < total ? (total - vcu + G - 1) / G : 0;
        if (tid < nun && tid < 64) {
            const int u = vcu + tid * G;
            int lo = 0, hi2 = 512;
            while (hi2 - lo > 1) { const int mid = (lo + hi2) >> 1; if (pre[mid] <= u) lo = mid; else hi2 = mid; }
            desc[tid * 4 + 0] = lo; desc[tid * 4 + 1] = u - pre[lo]; desc[tid * 4 + 2] = (int)cnt_sel[lo];
        }
        __syncthreads();
        if (nun > 0) {
            unsigned ent_c, ent_n = 0; bf16x8 qf[4], qn[4];
            {
                const int li = desc[0], cidx = desc[1], n = desc[2];
                const int bh = li >> 5, j = li & 31;
                attn_stage_kv(lds, z, (bh >> 3) * SEQ + j * 256, bh & 7);
                const int qb = cidx * 256 + wave * 32, qi = qb + r31;
                ent_c = sel_list[(size_t)li * 8192 + ((qi < n) ? qi : cidx * 256)];
                const bf16_t* qp = z + (size_t)((bh >> 3) * SEQ + (int)(ent_c & 8191u)) * ZLD + (bh & 7) * 64 + 8 * hh;
#pragma unroll
                for (int s2 = 0; s2 < 4; ++s2) qf[s2] = *(const bf16x8*)(qp + 16 * s2);
                if (nun > 1) { const int li1 = desc[4], c1 = desc[5], n1 = desc[6]; const int q1 = c1 * 256 + wave * 32 + r31;
                    ent_n = sel_list[(size_t)li1 * 8192 + ((q1 < n1) ? q1 : c1 * 256)]; }
            }
            for (int k = 0; k < nun; ++k) {
                asm volatile("s_waitcnt vmcnt(0)" ::: "memory");
                __syncthreads();
                LAS unsigned char* kvb = lds + (k & 1) * 65536;
                unsigned ent_nn = 0;
                if (k + 1 < nun) {
                    const int li1 = desc[(k + 1) * 4], bh1 = li1 >> 5, j1 = li1 & 31;
                    const bf16_t* qp = z + (size_t)((bh1 >> 3) * SEQ + (int)(ent_n & 8191u)) * ZLD + (bh1 & 7) * 64 + 8 * hh;
                    asm volatile("global_load_dwordx4 %0, %4, off\n\tglobal_load_dwordx4 %1, %4, off offset:32\n\tglobal_load_dwordx4 %2, %4, off offset:64\n\tglobal_load_dwordx4 %3, %4, off offset:96"
                                 : "=&v"(qn[0]), "=&v"(qn[1]), "=&v"(qn[2]), "=&v"(qn[3]) : "v"(qp) : "memory");
                    if (k + 2 < nun) { const int li2 = desc[(k + 2) * 4], c2 = desc[(k + 2) * 4 + 1], n2 = desc[(k + 2) * 4 + 2]; const int q2 = c2 * 256 + wave * 32 + r31;
                        const unsigned* ep = sel_list + (size_t)li2 * 8192 + ((q2 < n2) ? q2 : c2 * 256);
                        asm volatile("global_load_dword %0, %1, off" : "=&v"(ent_nn) : "v"(ep) : "memory"); }
                    asm volatile("" ::: "memory");
                    attn_stage_kv(lds + ((k + 1) & 1) * 65536, z, (bh1 >> 3) * SEQ + j1 * 256, bh1 & 7);
                    asm volatile("" ::: "memory");
                }
                const int li = desc[k * 4], cidx = desc[k * 4 + 1], n = desc[k * 4 + 2];
                const int bh = li >> 5, j = li & 31, hd = bh & 7;
                const int qbase = cidx * 256 + wave * 32;
                if (qbase < n) {
                    const bool valid = qbase + r31 < n;
                    const int sq = (int)(ent_c & 8191u), rank = (int)(ent_c >> 13);
                    const int dbase = sq - j * 256;
                    int dlo = dbase;
#pragma unroll
                    for (int o2 = 1; o2 < 64; o2 <<= 1) { const int t2 = __shfl_xor(dlo, o2); dlo = t2 < dlo ? t2 : dlo; }
                    dlo = __builtin_amdgcn_readfirstlane(dlo);
                    float mx, l; f32x16 o[2];
                    attn_block<HASDRY ? ATTN_STUB : 0>(kvb, qf, dbase, dlo, 7, tabl + hd * 132, mx, l, o);
                    {
                        const float inv = fast_rcp(l);
                        const unsigned pidx = valid ? (unsigned)(((size_t)bh * SEQ + sq) * 3 + rank) : 0xFFFFFFFFu;
                        LAS unsigned char* stg = lds + LDS_MISC + MISC_STG + wave * 2560;
#pragma unroll
                        for (int c = 0; c < 2; ++c) {
#pragma unroll
                            for (int g = 0; g < 4; ++g)
                                *(LAS u32x2*)(stg + r31 * 80 + (8 * g + 4 * hh) * 2) = (u32x2){pk2(o[c][4 * g] * inv, o[c][4 * g + 1] * inv), pk2(o[c][4 * g + 2] * inv, o[c][4 * g + 3] * inv)};
                            asm volatile("s_waitcnt lgkmcnt(0)" ::: "memory");
#pragma unroll
                            for (int i = 0; i < 2; ++i) {
                                const int row = i * 16 + (lane >> 2), chunk = lane & 3;
                                const u32x4 v = *(LAS u32x4*)(stg + row * 80 + chunk * 16);
                                const unsigned pr = (unsigned)__shfl((int)pidx, row);
                                if (pr != 0xFFFFFFFFu) *(u32x4*)(part_o + (size_t)pr * 64 + c * 32 + chunk * 8) = v;
                            }
                            asm volatile("s_waitcnt lgkmcnt(0)" ::: "memory");
                        }
                        if (valid && hh == 0) *(f32x2*)(part_ml + (size_t)pidx * 2) = (f32x2){mx + c31l[hd], l};
                    }
                }
                asm volatile("s_waitcnt vmcnt(0)" : "+v"(qn[0]), "+v"(qn[1]), "+v"(qn[2]), "+v"(qn[3]), "+v"(ent_nn) :: "memory");
                __builtin_amdgcn_sched_barrier(0);
                ent_c = ent_n; ent_n = ent_nn;
#pragma unroll
                for (int s2 = 0; s2 < 4; ++s2) qf[s2] = qn[s2];
            }
        }
        __syncthreads();
    }
    }
    if constexpr (!HASDRY) xcd_barrier(bar);
    {
        unsigned char* wsl = (unsigned char*)karg_ptr(168);
        x = (const float*)karg_ptr(8 * 0);
        tab = (float*)(wsl + WS_TAB);
        z = (bf16_t*)(wsl + WS_Z);
        part_o = (bf16_t*)(wsl + WS_PARTO);
        part_ml = (float*)(wsl + WS_PARTML);
        ab = (bf16_t*)(wsl + WS_AB);
    }

    if constexpr (PH(5)) {
    {
        LAS float* tabl = (LAS float*)(lds + LDS_MISC + MISC_TAB);
        __syncthreads();
        for (int i = tid; i < 8 * 132; i += NT) tabl[i] = tab[i];
        for (int pr = vcu; pr < 256; pr += G) {
            const int half = wave >> 2, wl = wave & 3;
            __syncthreads();
            {
                const int uA = 2 * pr, uB = 2 * pr + 1;
                attn_stage_kv(lds, z, ((uA >> 5) >> 3) * SEQ + (uA & 31) * 256, (uA >> 5) & 7);
                attn_stage_kv(lds + 65536, z, ((uB >> 5) >> 3) * SEQ + (uB & 31) * 256, (uB >> 5) & 7);
            }
            const int u = 2 * pr + half;
            const int bh = u >> 5, ob = u & 31, b = bh >> 3, hd = bh & 7;
            LAS unsigned char* kvb = lds + half * 65536;
            bf16x8 qfa[4], qfb[4];
            {
                const bf16_t* qp = z + (size_t)(b * SEQ + ob * 256 + wl * 32 + r31) * ZLD + hd * 64 + 8 * hh;
                const bf16_t* qp2 = z + (size_t)(b * SEQ + ob * 256 + (7 - wl) * 32 + r31) * ZLD + hd * 64 + 8 * hh;
#pragma unroll
                for (int s2 = 0; s2 < 4; ++s2) { qfa[s2] = *(const bf16x8*)(qp + 16 * s2); qfb[s2] = *(const bf16x8*)(qp2 + 16 * s2); }
            }
            asm volatile("s_waitcnt vmcnt(0)" ::: "memory");
            __syncthreads();
            const int nvalid = ob < 3 ? ob : 3;
#pragma unroll 1
            for (int pass = 0; pass < 2; ++pass) {
                const int qt = pass ? 7 - wl : wl;
                const int sq = ob * 256 + qt * 32 + r31;
                const size_t pbase = ((size_t)bh * SEQ + sq) * 3;
                float mr[3], lr[3];
#pragma unroll
                for (int r = 0; r < 3; ++r) { mr[r] = -INFINITY; lr[r] = 0.f; if (r < nvalid) { const f32x2 ml = *(const f32x2*)(part_ml + (pbase + r) * 2); mr[r] = ml.x; lr[r] = ml.y; } }
                float mx, l; f32x16 o[2];
                if (pass) attn_block<HASDRY ? ATTN_STUB : 0>(kvb, qfb, qt * 32 + r31, qt * 32, qt, tabl + hd * 132, mx, l, o);
                else      attn_block<HASDRY ? ATTN_STUB : 0>(kvb, qfa, qt * 32 + r31, qt * 32, qt, tabl + hd * 132, mx, l, o);
                float M = mx;
#pragma unroll
                for (int r = 0; r < 3; ++r) M = fmaxf(M, mr[r]);
                const float wo = fast_exp2(mx - M);
                float wr[3], den = l * wo;
#pragma unroll
                for (int r = 0; r < 3; ++r) { wr[r] = (r < nvalid) ? lr[r] * fast_exp2(mr[r] - M) : 0.f; den += wr[r]; }
                const float inv = 1.0f / den;
                const float a_o = wo * inv, a_0 = wr[0] * inv, a_1 = wr[1] * inv, a_2 = wr[2] * inv;
                LAS unsigned char* stg = lds + LDS_MISC + MISC_STG + wave * 2560;
                const size_t prow0 = ((size_t)bh * SEQ + ob * 256 + qt * 32) * 3;
                bf16_t* op0 = ab + (size_t)(b * SEQ + ob * 256 + qt * 32) * D + hd * 64;
#pragma unroll
                for (int c = 0; c < 2; ++c) {
#pragma unroll
                    for (int g = 0; g < 4; ++g)
                        *(LAS u32x2*)(stg + r31 * 80 + (8 * g + 4 * hh) * 2) = (u32x2){pk2(o[c][4 * g] * a_o, o[c][4 * g + 1] * a_o), pk2(o[c][4 * g + 2] * a_o, o[c][4 * g + 3] * a_o)};
                    asm volatile("s_waitcnt lgkmcnt(0)" ::: "memory");
#pragma unroll
                    for (int i = 0; i < 2; ++i) {
                        const int row = i * 16 + (lane >> 2), chunk = lane & 3;
                        const u32x4 own = *(LAS u32x4*)(stg + row * 80 + chunk * 16);
                        float f[8] = {bflo(own.x), bfhi(own.x), bflo(own.y), bfhi(own.y), bflo(own.z), bfhi(own.z), bflo(own.w), bfhi(own.w)};
#pragma unroll
                        for (int r = 0; r < 3; ++r)
                            if (r < nvalid) {
                                const float ar = __shfl(r == 0 ? a_0 : (r == 1 ? a_1 : a_2), row);
                                const u32x4 w = *(const u32x4*)(part_o + (prow0 + (size_t)row * 3 + r) * 64 + c * 32 + chunk * 8);
                                f[0] += ar * bflo(w.x); f[1] += ar * bfhi(w.x); f[2] += ar * bflo(w.y); f[3] += ar * bfhi(w.y);
                                f[4] += ar * bflo(w.z); f[5] += ar * bfhi(w.z); f[6] += ar * bflo(w.w); f[7] += ar * bfhi(w.w);
                            }
                        *(u32x4*)(op0 + (size_t)row * D + c * 32 + chunk * 8) = (u32x4){pk2(f[0], f[1]), pk2(f[2], f[3]), pk2(f[4], f[5]), pk2(f[6], f[7])};
                    }
                    asm volatile("s_waitcnt lgkmcnt(0)" ::: "memory");
                }
            }
        }
        __syncthreads();
    }
    }
    if constexpr (!HASDRY) xcd_barrier(bar);
    {
        unsigned char* wsl = (unsigned char*)karg_ptr(168);
        x = (const float*)karg_ptr(8 * 0);
        g_ffn = (const float*)karg_ptr(8 * 8);
        w_gate = (const float*)karg_ptr(8 * 13);
        w_up = (const float*)karg_ptr(8 * 14);
        w_down = (const float*)karg_ptr(8 * 15);
        out = (float*)karg_ptr(160);
        ss1 = (float*)(wsl + WS_SS1P);
        WoutT = (bf16_t*)(wsl + WS_WOUT);
        xb = (bf16_t*)(wsl + WS_XB);
        WguT = (bf16_t*)(wsl + WS_Z);
        WdT = (bf16_t*)(wsl + WS_PARTO);
        ab = (bf16_t*)(wsl + WS_AB);
    }

    if constexpr (PH(6)) {
    {
        {
            SchedDense S6{64, 4, G, (int)blockIdx.x, 1024, (const unsigned char*)WoutT};
            gemm8(lds, (const unsigned char*)ab, 1024, S6, EpiX1{xb, ss1, dry});
        }
        __syncthreads();
        LAS float* tl = (LAS float*)lds;
        {
            f32x4 vc[8], vn[8];
            int it = vcu;
            if (it < 2048) { const int kind = it >> 10, r = it & 1023, e = r >> 5, tt = r & 31;
                transpose_load(vc, (kind ? w_up : w_gate) + (size_t)e * 1024 * 512, 512, (tt >> 1) * 64, (tt & 1) * 256); }
            for (; it < 2048; it += G) {
                const int nx = it + G;
                if (nx < 2048) { const int kind = nx >> 10, r = nx & 1023, e = r >> 5, tt = r & 31;
                    transpose_load(vn, (kind ? w_up : w_gate) + (size_t)e * 1024 * 512, 512, (tt >> 1) * 64, (tt & 1) * 256); }
                { const int kind = it >> 10, r = it & 1023, e = r >> 5, tt = r & 31;
                  transpose_finish(vc, 1024, WguT + (size_t)e * 1024 * 1024, (tt >> 1) * 64, (tt & 1) * 256, g_ffn, kind ? 2 : 1, tl); }
#pragma unroll
                for (int i = 0; i < 8; ++i) vc[i] = vn[i];
            }
        }
    }
    }
    if constexpr (!HASDRY) xcd_barrier(bar);
    {
        unsigned char* wsl = (unsigned char*)karg_ptr(168);
        cnt_exp = (unsigned*)(wsl + OFF_CNT_EXP);
        ss1 = (float*)(wsl + WS_SS1P);
        routeb = (float*)(wsl + WS_RB);
        WrT = (bf16_t*)(wsl + WS_WR);
        xb = (bf16_t*)(wsl + WS_XB);
        tok_list = (unsigned*)(wsl + WS_TOK);
        gate_list = (float*)(wsl + WS_GW);
        rstd0 = (float*)(wsl + WS_RSTD0);
    }

    if constexpr (PH(7)) {
    {
        LAS float* lgp = (LAS float*)(lds + 98304);
        LAS unsigned char* wr_l = lds;
        LAS unsigned* hist = (LAS unsigned*)marr;
        __syncthreads();
#pragma unroll
        for (int i = 0; i < 12; ++i) {
            const int pc = wave * 12 + i, row = pc >> 1, dc = (pc & 1) * 64 + lane;
            __builtin_amdgcn_global_load_lds((const unsigned*)(WrT + (size_t)row * 1024 + (dc ^ (row & 7)) * 8), (LAS unsigned*)(wr_l + pc * 1024), 16, 0, 0);
        }
        asm volatile("s_waitcnt vmcnt(0)" ::: "memory");
        __syncthreads();
        for (int ug = vcu; ug < 256; ug += G) {
            __syncthreads();
            if (tid < 32) hist[tid] = 0u;
            const int grp = ug * 4 + (wave >> 1), khalf = wave & 1;
            const int m0 = grp * 16;
            f32x4 ac[3];
#pragma unroll
            for (int n = 0; n < 3; ++n) ac[n] = (f32x4){0.f, 0.f, 0.f, 0.f};
            const bf16_t* ap = xb + (size_t)(m0 + fr) * D + khalf * 512 + fq * 8;
            bf16x8 af[16];
#pragma unroll
            for (int ks = 0; ks < 16; ++ks) af[ks] = *(const bf16x8*)(ap + ks * 32);
#pragma unroll
            for (int ks = 0; ks < 16; ++ks) {
#pragma unroll
                for (int n = 0; n < 3; ++n) {
                    const int row = n * 16 + fr, ch = khalf * 64 + ks * 4 + fq;
                    const bf16x8 bf = *(LAS bf16x8*)(wr_l + row * 2048 + ((ch ^ (row & 7)) << 4));
                    ac[n] = mfma16(af[ks], bf, ac[n]);
                }
            }
#pragma unroll
            for (int n = 0; n < 3; ++n)
#pragma unroll
                for (int r = 0; r < 4; ++r) lgp[wave * 768 + (fq * 4 + r) * 48 + n * 16 + fr] = ac[n][r];
            __syncthreads();
            int e0 = 0, e1 = 0; float g0 = 0.f, g1 = 0.f; unsigned lp0 = 0, lp1 = 0; int token = 0;
            const bool act = (khalf == 0) && (lane < 16);
            if (act) {
                token = m0 + lane;
                float ssum = 0.f;
                { const f32x4* pp4 = (const f32x4*)(ss1 + (size_t)token * 16); const f32x4 p0 = pp4[0], p1 = pp4[1], p2 = pp4[2], p3 = pp4[3];
                  ssum = ((p0.x + p0.y) + (p0.z + p0.w)) + ((p1.x + p1.y) + (p1.z + p1.w)) + ((p2.x + p2.y) + (p2.z + p2.w)) + ((p3.x + p3.y) + (p3.z + p3.w)); }
                const float rs = rsqrtf(ssum * (1.0f / D) + EPS);
                if (!dry) rstd0[token] = rs;
                float lg[36];
#pragma unroll
                for (int c = 0; c < 36; ++c) lg[c] = (lgp[wave * 768 + lane * 48 + c] + lgp[(wave + 1) * 768 + lane * 48 + c]) * rs + routeb[c];
                int gs = 0; float gm = lg[0];
#pragma unroll
                for (int c = 1; c < 4; ++c) if (lg[c] > gm) { gm = lg[c]; gs = c; }
                float se = 0.f;
#pragma unroll
                for (int c = 0; c < 4; ++c) se += __expf(lg[c] - gm);
                const float pg = 1.0f / se;
                float l2[8];
#pragma unroll
                for (int c = 0; c < 8; ++c) l2[c] = gs == 0 ? lg[4 + c] : (gs == 1 ? lg[12 + c] : (gs == 2 ? lg[20 + c] : lg[28 + c]));
                int a0 = 0; float va = l2[0];
#pragma unroll
                for (int c = 1; c < 8; ++c) if (l2[c] > va) { va = l2[c]; a0 = c; }
                int a1 = -1; float vb = -INFINITY;
#pragma unroll
                for (int c = 0; c < 8; ++c) if (c != a0 && l2[c] > vb) { vb = l2[c]; a1 = c; }
                const float wa = 1.0f / (1.0f + __expf(vb - va));
                e0 = gs * 8 + a0; e1 = gs * 8 + a1; g0 = pg * wa; g1 = pg * (1.0f - wa);
                if (dry) { if (g0 + g1 == 12345.f) cnt_exp[0] = (unsigned)(e0 + e1); }
                else { lp0 = atomicAdd((unsigned*)&hist[e0], 1u);
                lp1 = atomicAdd((unsigned*)&hist[e1], 1u); }
            }
            __syncthreads();
            if (tid < 32) { const unsigned c = hist[tid]; hist[32 + tid] = c ? atomicAdd(&cnt_exp[tid], c) : 0u; }
            __syncthreads();
            if (act && !dry) {
                const unsigned p0 = hist[32 + e0] + lp0, p1 = hist[32 + e1] + lp1;
                tok_list[e0 * 16384 + p0] = (unsigned)token; gate_list[e0 * 16384 + p0] = g0;
                tok_list[e1 * 16384 + p1] = (unsigned)token | (1u << 14); gate_list[e1 * 16384 + p1] = g1;
            }
        }
    }
    }
    if constexpr (!HASDRY) xcd_barrier(bar);
    {
        unsigned char* wsl = (unsigned char*)karg_ptr(168);
        x = (const float*)karg_ptr(8 * 0);
        cnt_exp = (unsigned*)(wsl + OFF_CNT_EXP);
        ss1 = (float*)(wsl + WS_SS1P);
        xb = (bf16_t*)(wsl + WS_XB);
        WguT = (bf16_t*)(wsl + WS_Z);
        tok_list = (unsigned*)(wsl + WS_TOK);
        gate_list = (float*)(wsl + WS_GW);
        hid = (bf16_t*)(wsl + WS_AB);
        w_down = (const float*)karg_ptr(8 * 15);
        WdT = (bf16_t*)(wsl + WS_PARTO);
        pb = (bf16_t*)(wsl + WS_PB);
        ppb = (bf16_t*)(wsl + WS_PP);
        WpleT = (bf16_t*)(wsl + WS_WPLE);
        rstd0 = (float*)(wsl + WS_RSTD0);
    }

    LAS int* ecnt = marr;
    LAS int* epre = marr + 32;
    LAS int* ehoff = marr + 72;
    __syncthreads();
    if (wave == 0) {
        const int c = lane < 32 ? (int)cnt_exp[lane] : 0;
        int tp2 = ((c + 255) >> 8) * 4, ho = c;
#pragma unroll
        for (int o2 = 1; o2 < 64; o2 <<= 1) { const int a2 = __shfl_up(tp2, o2), b2 = __shfl_up(ho, o2); if (lane >= o2) { tp2 += a2; ho += b2; } }
        if (lane < 32) { ecnt[lane] = c; epre[lane + 1] = tp2; ehoff[lane + 1] = ho; }
        if (lane == 0) { epre[0] = 0; ehoff[0] = 0; }
    }
    __syncthreads();
    if constexpr (PH(8)) {
        SchedMoe S8{ecnt, epre, ehoff, G, (int)blockIdx.x, 1024, (const unsigned char*)WguT, (size_t)1024 * 1024 * 2, tok_list, 0};
        gemm8(lds, (const unsigned char*)xb, 1024, S8, EpiHid{hid, tok_list, gate_list, rstd0, ehoff});
        {
            const int nwg8 = epre[32], c8 = (int)blockIdx.x;
            const int nmax = (nwg8 + G - 1) / G, nheavy = nwg8 - (nmax - 1) * G;
            const int nlight = nheavy >= G ? G : G - nheavy, li = nheavy >= G ? c8 : c8 - nheavy;
            if (li >= 0) {
                f32x4 vc[8], vn[8];
                int it = li;
                if (it < 1024) { const int e = it >> 5, tt = it & 31; transpose_load(vc, w_down + (size_t)e * 512 * 1024, 1024, (tt >> 2) * 64, (tt & 3) * 256); }
                for (; it < 1024; it += nlight) {
                    const int nx = it + nlight;
                    if (nx < 1024) { const int e = nx >> 5, tt = nx & 31; transpose_load(vn, w_down + (size_t)e * 512 * 1024, 1024, (tt >> 2) * 64, (tt & 3) * 256); }
                    { const int e = it >> 5, tt = it & 31; transpose_finish(vc, 512, WdT + (size_t)e * 1024 * 512, (tt >> 2) * 64, (tt & 3) * 256, nullptr, 0, (LAS float*)lds); }
#pragma unroll
                    for (int i = 0; i < 8; ++i) vc[i] = vn[i];
                }
            }
        }
    }
    if constexpr (!HASDRY) xcd_barrier(bar);
    {
        unsigned char* wsl = (unsigned char*)karg_ptr(168);
        x = (const float*)karg_ptr(8 * 0);
        yslot = (bf16_t*)(wsl + WS_Z);
        tok_list = (unsigned*)(wsl + WS_TOK);
        WdT = (bf16_t*)(wsl + WS_PARTO);
        hid = (bf16_t*)(wsl + WS_AB);
        pb = (bf16_t*)(wsl + WS_PB);
        ppb = (bf16_t*)(wsl + WS_PP);
        WpleT = (bf16_t*)(wsl + WS_WPLE);
    }
    if constexpr (PH(9)) {
        SchedMoe S9{ecnt, epre, ehoff, G, (int)blockIdx.x, 512, (const unsigned char*)WdT, (size_t)1024 * 512 * 2, tok_list, 1};
        gemm8(lds, (const unsigned char*)hid, 512, S9, EpiY{yslot, tok_list});
        {
            const int nwg9 = epre[32], c9 = (int)blockIdx.x;
            const int nmax = (nwg9 + G - 1) / G, nheavy = nwg9 - (nmax - 1) * G;
            const int nlight = nheavy >= G ? G : G - nheavy, li = nheavy >= G ? c9 : c9 - nheavy;
            SchedLight S2{64, 4, 256, li, nlight, li >= 0, (const unsigned char*)WpleT};
            gemm8(lds, (const unsigned char*)pb, 256, S2, EpiBf16Plain{ppb, D});
        }
    }
    if constexpr (!HASDRY) xcd_barrier(bar);
    {
        unsigned char* wsl = (unsigned char*)karg_ptr(168);
        x = (const float*)karg_ptr(8 * 0);
        out = (float*)karg_ptr(160);
        rstd2 = (float*)(wsl + WS_RSTD2);
        xb = (bf16_t*)(wsl + WS_XB);
        z = (bf16_t*)(wsl + WS_Z);
        yslot = (bf16_t*)(wsl + WS_Z);
    }

    if constexpr (PH(10)) {
    for (int row = (vcu * 8 + wave) * 2; row < T; row += G * 16) {
        u32x2* xr = (u32x2*)(xb + (size_t)row * D) + lane;
        const u32x2* y0 = (const u32x2*)(yslot + (size_t)row * D) + lane;
        const u32x2* y1 = (const u32x2*)(yslot + ((size_t)T + row) * D) + lane;
        u32x2 xv[8], a[8], c[8];
#pragma unroll
        for (int j = 0; j < 8; ++j) { xv[j] = xr[64 * j]; a[j] = y0[64 * j]; c[j] = y1[64 * j]; }
        float s0 = 0.f, s1 = 0.f;
#pragma unroll
        for (int j = 0; j < 8; ++j) {
            const float vx = bflo(xv[j].x) + bflo(a[j].x) + bflo(c[j].x), vy = bfhi(xv[j].x) + bfhi(a[j].x) + bfhi(c[j].x);
            const float vz = bflo(xv[j].y) + bflo(a[j].y) + bflo(c[j].y), vw = bfhi(xv[j].y) + bfhi(a[j].y) + bfhi(c[j].y);
            if (!dry) xr[64 * j] = (u32x2){pk2(vx, vy), pk2(vz, vw)};
            const float q = (vx * vx + vy * vy) + (vz * vz + vw * vw);
            if (j < 4) s0 += q; else s1 += q;
        }
        s0 = wave_sum(s0); s1 = wave_sum(s1);
        if (lane == 0 && !dry) { rstd2[row] = rsqrtf(s0 * (1.0f / D) + EPS); rstd2[row + 1] = rsqrtf(s1 * (1.0f / D) + EPS); }
    }
    }
    if constexpr (!HASDRY) xcd_barrier(bar);
    {
        unsigned char* wsl = (unsigned char*)karg_ptr(168);
        x = (const float*)karg_ptr(8 * 0);
        out = (float*)karg_ptr(160);
        ss3 = (float*)(wsl + OFF_SS3);
        rstd2 = (float*)(wsl + WS_RSTD2);
        WpgT = (bf16_t*)(wsl + WS_WPG);
        xb = (bf16_t*)(wsl + WS_XB);
        ppb = (bf16_t*)(wsl + WS_PP);
        g_final = (const float*)karg_ptr(8 * 19);
    }

    if constexpr (PH(11)) {
    {
        SchedDense S11{64, 4, G, (int)blockIdx.x, 1024, (const unsigned char*)WpgT};
        if (G == 256) gemm8(lds, (const unsigned char*)xb, 1024, S11, EpiX3F{xb, out, ppb, rstd2, ss3, (unsigned*)(ws + OFF_PCNT), g_final});
        else gemm8(lds, (const unsigned char*)xb, 1024, S11, EpiX3{xb, out, ppb, rstd2, ss3, dry});
    }
    }
    if constexpr (!HASDRY) { if (G != 256) xcd_barrier(bar); }
    {
        unsigned char* wsl = (unsigned char*)karg_ptr(168);
        g_final = (const float*)karg_ptr(8 * 19);
        out = (float*)karg_ptr(160);
        ss3 = (float*)(wsl + OFF_SS3);
    }

    if constexpr (PH(12)) {
    if (G != 256)
    for (int row = vcu * 8 + wave; row < T; row += G * 8) {
        f32x4* xr = (f32x4*)(out + (size_t)row * D) + lane;
        const f32x4* gf = (const f32x4*)g_final + lane;
        const float rs = rsqrtf(ss3[row] * (1.0f / D) + EPS);
#pragma unroll
        for (int j = 0; j < 4; ++j) { f32x4 v = xr[64 * j]; const f32x4 g = gf[64 * j]; v = v * rs * g; if (!dry) xr[64 * j] = v; }
    }
    }
}

extern "C" void kernel_launch(void* const* d_in, const int* in_sizes, int n_in, void* d_out, int out_size, void* d_ws, size_t ws_size, hipStream_t stream) {
    static int grid = 0;
    if (grid == 0) {
        int dev = 0, cus = 0, per_cu = 0;
        if (n_in != 20 || out_size != T * D || ws_size < WS_END) { fprintf(stderr, "kernel_launch: unexpected shapes (n_in %d out %d ws %zu)\n", n_in, out_size, ws_size); grid = -1; return; }
        if (hipGetDevice(&dev) != hipSuccess || hipDeviceGetAttribute(&cus, hipDeviceAttributeMultiprocessorCount, dev) != hipSuccess) { grid = -1; return; }
        if (hipFuncSetAttribute((const void*)hymba_fwd<0x1FFFu, false>, hipFuncAttributeMaxDynamicSharedMemorySize, LDS_BYTES) != hipSuccess) { fprintf(stderr, "kernel_launch: hipFuncSetAttribute failed\n"); grid = -1; return; }
        if (hipOccupancyMaxActiveBlocksPerMultiprocessor(&per_cu, (const void*)hymba_fwd<0x1FFFu, false>, NT, LDS_BYTES) != hipSuccess || per_cu < 1) { fprintf(stderr, "kernel_launch: occupancy query says %d blocks per CU\n", per_cu); (void)hipGetLastError(); grid = -1; return; }
        grid = cus;
    }
    if (grid < 0) return;
    (void)hipMemsetAsync((char*)d_ws + WS_CTL, 0, CTL_BYTES, stream);
    Params p{};
    for (int i = 0; i < 20; ++i) p.in[i] = (const float*)d_in[i];
    p.out = (float*)d_out; p.ws = (unsigned char*)d_ws;
    hipLaunchKernelGGL((hymba_fwd<0x1FFFu, false>), dim3(grid), dim3(NT), LDS_BYTES, stream, p);
#if PROF_PHASES
    p.dry = 1;
#define PROF_ONE(k) do { if (PROF_PHASES & (1u << (k))) { (void)hipFuncSetAttribute((const void*)hymba_fwd<(1u << (k)), true>, hipFuncAttributeMaxDynamicSharedMemorySize, LDS_BYTES); \
        hipLaunchKernelGGL((hymba_fwd<(1u << (k)), true>), dim3(grid), dim3(NT), LDS_BYTES, stream, p); } } while (0)
    PROF_ONE(0); PROF_ONE(1); PROF_ONE(2); PROF_ONE(3); PROF_ONE(4); PROF_ONE(5); PROF_ONE(6); PROF_ONE(7); PROF_ONE(8); PROF_ONE(9); PROF_ONE(10); PROF_ONE(11); PROF_ONE(12);
#endif
}
```

```cpp
#include <hip/hip_runtime.h>
#include <stdint.h>
#include <stdio.h>

#define DI __device__ __forceinline__
#define LAS __attribute__((address_space(3)))

typedef unsigned short bf16_t;
typedef short bf16x8 __attribute__((ext_vector_type(8)));
typedef short s16x4 __attribute__((ext_vector_type(4)));
typedef float f32x2 __attribute__((ext_vector_type(2)));
typedef float f32x4 __attribute__((ext_vector_type(4)));
typedef float f32x16 __attribute__((ext_vector_type(16)));
typedef unsigned u32x2 __attribute__((ext_vector_type(2)));
typedef unsigned u32x4 __attribute__((ext_vector_type(4)));

constexpr int T = 16384, D = 1024, SEQ = 8192, NH = 8, NBLK = 32;
constexpr int ZLD = 2048;
constexpr float EPS = 1e-6f;
constexpr float LOG2E = 1.4426950408889634f;
constexpr int NT = 512;
#define PH(k) (((MASK) >> (k)) & 1)
#ifndef PROF_PHASES
#define PROF_PHASES 0
#endif

constexpr size_t MiB = 1u << 20;
constexpr size_t WS_CTL = 0, CTL_BYTES = 1 * MiB;
constexpr size_t OFF_CNT_SEL = 16384;
constexpr size_t OFF_CNT_EXP = 20480;
constexpr size_t OFF_PCNT = 24576;
constexpr size_t OFF_SS1 = 65536;
constexpr size_t OFF_SS3 = 131072;
constexpr size_t WS_KMEAN = 1 * MiB;
constexpr size_t WS_TAB = WS_KMEAN + 131072;
constexpr size_t WS_RSTD0 = WS_KMEAN + 196608;
constexpr size_t WS_RSTD2 = WS_KMEAN + 262144;
constexpr size_t WS_RB = WS_KMEAN + 327680;
constexpr size_t WS_SS1P = 2 * MiB;
constexpr size_t WS_WIN = 4 * MiB;
constexpr size_t WS_WOUT = 8 * MiB;
constexpr size_t WS_WPG = 10 * MiB;
constexpr size_t WS_WPLE = 12 * MiB;
constexpr size_t WS_WPOOL = 12 * MiB + 524288;
constexpr size_t WS_WR = 12 * MiB + 786432;
constexpr size_t WS_XB = 16 * MiB;
constexpr size_t WS_Z = 48 * MiB;
constexpr size_t WS_TOK = 112 * MiB;
constexpr size_t WS_GW = 114 * MiB;
constexpr size_t WS_SEL = 128 * MiB;
constexpr size_t WS_PARTO = 144 * MiB;
constexpr size_t WS_PARTML = 192 * MiB;
constexpr size_t WS_AB = 197 * MiB;
constexpr size_t WS_PB = 229 * MiB;
constexpr size_t WS_PP = 237 * MiB;
constexpr size_t WS_END = 269 * MiB;

constexpr int LDS_MISC = 131072;
constexpr int LDS_BYTES = 163840;
constexpr int MISC_ARR = 64;
constexpr int MISC_TAB = 4096;
constexpr int MISC_DESC = 8704;
constexpr int MISC_TBR = 10240;
constexpr int MISC_STG = 12288;

DI unsigned pk2(float lo, float hi) {
    typedef __bf16 b2 __attribute__((ext_vector_type(2)));
    f32x2 v = {lo, hi};
    b2 b = __builtin_convertvector(v, b2);
    return __builtin_bit_cast(unsigned, b);
}
DI float bflo(unsigned w) { return __uint_as_float(w << 16); }
DI float bfhi(unsigned w) { return __uint_as_float(w & 0xffff0000u); }
DI float wave_sum(float v) {
#pragma unroll
    for (int o = 1; o < 64; o <<= 1) v += __shfl_xor(v, o);
    return v;
}
DI f32x4 mfma16(bf16x8 a, bf16x8 b, f32x4 c) { return __builtin_amdgcn_mfma_f32_16x16x32_bf16(a, b, c, 0, 0, 0); }
DI f32x16 mfma32(bf16x8 a, bf16x8 b, f32x16 c) { return __builtin_amdgcn_mfma_f32_32x32x16_bf16(a, b, c, 0, 0, 0); }
DI float fast_exp2(float x) { return __builtin_amdgcn_exp2f(x); }
DI float fast_rcp(float x) { return __builtin_amdgcn_rcpf(x); }

#define XB_TMO      128
#define XB_XCNT(j)  (256  + 64 * (j))
#define XB_XSUB(j)  (1280 + 64 * (j))
#define XB_XGEN(j)  (2304 + 64 * (j))
#define XB_TOP      3328
#define XB_TOPGEN   3392
#define XCD_BAR_WORDS 3456
#define XB_SPIN_CAP (1u << 18)
DI unsigned xb_ld(unsigned* p)              { return __hip_atomic_load(p, __ATOMIC_RELAXED, __HIP_MEMORY_SCOPE_AGENT); }
DI unsigned xb_add(unsigned* p, unsigned v) { return __hip_atomic_fetch_add(p, v, __ATOMIC_RELAXED, __HIP_MEMORY_SCOPE_AGENT); }
DI unsigned xb_xcc_id() { return (unsigned)__builtin_amdgcn_s_getreg((3 << 11) | 20) & 0xFu; }
#define XB_SPIN(cond, bar) do { unsigned _sp = 0; while (cond) { __builtin_amdgcn_s_sleep(1); \
    if ((++_sp & 255u) == 0u) { if (xb_ld(&(bar)[XB_TMO])) break; if (_sp > XB_SPIN_CAP) { atomicAdd(&(bar)[XB_TMO], 1u); break; } } } } while (0)
struct XcdBarrier { unsigned* bar; unsigned x; volatile LAS unsigned* st; };
DI XcdBarrier xcd_barrier_post(unsigned* bar, volatile LAS unsigned* st) {
    XcdBarrier b; b.bar = bar; b.x = xb_xcc_id(); b.st = st;
    if (threadIdx.x == 0) (void)xb_add(&bar[XB_XCNT(b.x)], 1u);
    return b;
}
DI void xcd_barrier_complete(unsigned* bar, unsigned x, unsigned& nloc, unsigned& nx) {
    const unsigned G = gridDim.x * gridDim.y * gridDim.z;
    unsigned sum, cnt, mine, sp = 0u;
    for (;;) {
        sum = 0u; cnt = 0u; mine = 0u;
#pragma unroll
        for (unsigned j = 0; j < 16; ++j) { const unsigned c = xb_ld(&bar[XB_XCNT(j)]); sum += c; cnt += (c > 0u) ? 1u : 0u; mine = (j == x) ? c : mine; }
        if (sum == G) break;
        __builtin_amdgcn_s_sleep(1);
        if ((++sp & 255u) == 0u) { if (xb_ld(&bar[XB_TMO])) break; if (sp > XB_SPIN_CAP) { atomicAdd(&bar[XB_TMO], 1u); break; } }
    }
    nloc = mine > 0u ? mine : 1u; nx = cnt > 0u ? cnt : 1u;
}
DI void xcd_barrier(const XcdBarrier& b) {
    asm volatile("s_waitcnt vmcnt(0)" ::: "memory");
    __syncthreads();
    if (threadIdx.x == 0) {
        unsigned* bar = b.bar;
        __builtin_amdgcn_s_waitcnt(0);
        unsigned nloc = b.st[0], nx = b.st[1];
        if (nloc == 0u) { xcd_barrier_complete(bar, b.x, nloc, nx); b.st[0] = nloc; b.st[1] = nx; }
        const unsigned old = xb_add(&bar[XB_XSUB(b.x)], 1u);
        const unsigned gen = old / nloc;
        if (old + 1u == (gen + 1u) * nloc) {
            __builtin_amdgcn_fence(__ATOMIC_RELEASE, "agent");
            asm volatile("s_waitcnt vmcnt(0)" ::: "memory");
            const unsigned og = xb_add(&bar[XB_TOP], 1u);
            const unsigned tg = og / nx;
            if (og + 1u == (tg + 1u) * nx) xb_add(&bar[XB_TOPGEN], 1u);
            else XB_SPIN(xb_ld(&bar[XB_TOPGEN]) == tg, bar);
            __builtin_amdgcn_fence(__ATOMIC_ACQUIRE, "agent");
            xb_add(&bar[XB_XGEN(b.x)], 1u);
            asm volatile("s_waitcnt vmcnt(0)" ::: "memory");
        } else {
            XB_SPIN(xb_ld(&bar[XB_XGEN(b.x)]) == gen, bar);
            __builtin_amdgcn_fence(__ATOMIC_ACQUIRE, "agent");
            asm volatile("s_waitcnt vmcnt(0)" ::: "memory");
        }
    }
    __syncthreads();
}

constexpr int G8_HTB = 16384;
DI int g8_lds_byte(int r, int c) { const int st = (r >> 4) * 2 + (c >> 5), rr = r & 15, cc = c & 31, ob = rr * 64 + cc * 2; return st * 1024 + (ob ^ (((ob >> 9) & 1) << 5)); }
DI void g8_stage_rc(int b, int& R, int& C) { const int st = b / 1024, sb = b % 1024, swz = sb ^ (((sb >> 9) & 1) << 5); R = (st >> 1) * 16 + swz / 64; C = (st & 1) * 32 + (swz % 64) / 2; }
struct GUnit { int pm, pn, e, cnt; const unsigned char* bptr; };
template <class Sched, class Epi>
DI void gemm8(LAS unsigned char* lds, const unsigned char* Abase, const int K, const Sched& S, const Epi& E) {
    const int tid = threadIdx.x, wid = __builtin_amdgcn_readfirstlane(tid >> 6), lane = tid & 63, wr = wid >> 2, wc = wid & 3, fr = lane & 15, fq = lane >> 4;
    const int nt = K / 64;
    int sR[2], sC[2]; unsigned voffB[2];
#pragma unroll
    for (int i = 0; i < 2; ++i) { g8_stage_rc(tid * 16 + i * 8192, sR[i], sC[i]);
        const int rho = sR[i] & 31, rb = (sR[i] & ~31) + 8 * ((rho & 15) >> 2) + 4 * (rho >> 4) + (rho & 3);
        voffB[i] = (unsigned)(rb * K + sC[i]) * 2u; }
    const unsigned kstep = 128u;
    const size_t hstep = (size_t)128 * K * 2;
    const unsigned ldsw = (unsigned)wid * 1024u;
    const int aoff = g8_lds_byte(wr * 64 + fr, fq * 8), boff = g8_lds_byte(wc * 32 + fr, fq * 8);
#define G8_SA(b, h) (((b) * 2 + (h)) * G8_HTB)
#define G8_SB(b, h) ((4 + (b) * 2 + (h)) * G8_HTB)
#define G8_STAGE_B(bufoff, gbase) do { _Pragma("unroll") for (int _i = 0; _i < 2; ++_i) \
        __builtin_amdgcn_global_load_lds((const unsigned*)((gbase) + voffB[_i]), (LAS unsigned*)(lds + (bufoff) + ldsw + _i * 8192), 16, 0, 0); } while (0)
#define G8_STAGE_A(bufoff, o0, o1, kb) do { \
        __builtin_amdgcn_global_load_lds((const unsigned*)(Abase + (o0) + (kb)), (LAS unsigned*)(lds + (bufoff) + ldsw), 16, 0, 0); \
        __builtin_amdgcn_global_load_lds((const unsigned*)(Abase + (o1) + (kb)), (LAS unsigned*)(lds + (bufoff) + ldsw + 8192), 16, 0, 0); } while (0)
#define G8_LDA(dst, b, h) do { _Pragma("unroll") for (int m = 0; m < 4; ++m) _Pragma("unroll") for (int k = 0; k < 2; ++k) dst[m][k] = *(const LAS bf16x8*)(lds + G8_SA(b, h) + aoff + m * 2048 + k * 1024); } while (0)
#define G8_LDB(dst, b, h) do { _Pragma("unroll") for (int n = 0; n < 2; ++n) _Pragma("unroll") for (int k = 0; k < 2; ++k) dst[n][k] = *(const LAS bf16x8*)(lds + G8_SB(b, h) + boff + n * 2048 + k * 1024); } while (0)
#define G8_MMA(ai, bj, At, Bt) do { __builtin_amdgcn_s_setprio(1); _Pragma("unroll") for (int m = 0; m < 4; ++m) _Pragma("unroll") for (int n = 0; n < 2; ++n) _Pragma("unroll") for (int k = 0; k < 2; ++k) \
        acc[ai][bj][m][n] = __builtin_amdgcn_mfma_f32_16x16x32_bf16(Bt[n][k], At[m][k], acc[ai][bj][m][n], 0, 0, 0); __builtin_amdgcn_s_setprio(0); } while (0)
#define G8_WAIT_V(n) asm volatile("s_waitcnt vmcnt(" #n ")" ::: "memory")
#define G8_WAIT_L(n) asm volatile("s_waitcnt lgkmcnt(" #n ")" ::: "memory")
#define G8_BAR __builtin_amdgcn_s_barrier()
#define G8_SCHED __builtin_amdgcn_sched_barrier(0)
    GUnit cur, nxt; int ui = 0;
    if (!S.next(0, cur)) return;
    f32x4 acc[2][2][4][2];
#pragma unroll
    for (int a = 0; a < 2; ++a)
#pragma unroll
        for (int b = 0; b < 2; ++b)
#pragma unroll
            for (int m = 0; m < 4; ++m)
#pragma unroll
                for (int n = 0; n < 2; ++n) acc[a][b][m][n] = (f32x4){0.f, 0.f, 0.f, 0.f};
    bf16x8 At[4][2], B0[2][2], B1[2][2];
    unsigned oc[2][2], on[2][2];
    S.aoffs(cur, sR, sC, oc);
    const unsigned char* cB = cur.bptr;
    G8_STAGE_B(G8_SB(0, 0), cB); G8_STAGE_B(G8_SB(0, 1), cB + hstep); G8_STAGE_A(G8_SA(0, 0), oc[0][0], oc[0][1], 0u); G8_STAGE_A(G8_SA(0, 1), oc[1][0], oc[1][1], 0u);
    if (wr == 1) G8_BAR;
    G8_WAIT_V(2); G8_BAR;
    G8_STAGE_B(G8_SB(1, 0), cB + kstep); G8_STAGE_A(G8_SA(1, 0), oc[0][0], oc[0][1], kstep); G8_STAGE_B(G8_SB(1, 1), cB + hstep + kstep);
    G8_WAIT_V(6); G8_BAR;
    for (;;) {
        const bool has_next = S.next(ui + 1, nxt);
        if (has_next) S.aoffs(nxt, sR, sC, on);
        else {
#pragma unroll
            for (int h = 0; h < 2; ++h)
#pragma unroll
                for (int i = 0; i < 2; ++i) on[h][i] = oc[h][i];
        }
        const unsigned char* nB = has_next ? nxt.bptr : cB;
#pragma unroll 1
        for (int t = 0; t < nt; t += 2) {
            const bool last = (t == nt - 2);
            const unsigned k1 = (unsigned)(t + 1) * kstep;
            const unsigned k2 = last ? 0u : (unsigned)(t + 2) * kstep, k3 = k2 + kstep;
            const unsigned a2_00 = last ? on[0][0] : oc[0][0], a2_01 = last ? on[0][1] : oc[0][1], a2_10 = last ? on[1][0] : oc[1][0], a2_11 = last ? on[1][1] : oc[1][1];
            const unsigned char* b2 = (last ? nB : cB) + k2; const unsigned char* b3 = b2 + kstep;
            G8_LDB(B0, 0, 0); G8_LDB(B1, 0, 1); G8_SCHED; G8_LDA(At, 0, 0); G8_STAGE_A(G8_SA(1, 1), oc[1][0], oc[1][1], k1);
            G8_WAIT_V(8); G8_WAIT_L(0); G8_BAR; G8_MMA(0, 0, At, B0); G8_MMA(0, 1, At, B1); G8_BAR; G8_SCHED;
            G8_LDA(At, 0, 1); G8_STAGE_B(G8_SB(0, 0), b2); G8_STAGE_B(G8_SB(0, 1), b2 + hstep); G8_STAGE_A(G8_SA(0, 0), a2_00, a2_01, k2);
            G8_WAIT_V(8); G8_WAIT_L(0); G8_BAR; G8_MMA(1, 0, At, B0); G8_MMA(1, 1, At, B1); G8_BAR; G8_SCHED;
            G8_LDB(B0, 1, 0); G8_LDB(B1, 1, 1); G8_SCHED; G8_LDA(At, 1, 0); G8_STAGE_A(G8_SA(0, 1), a2_10, a2_11, k2);
            G8_WAIT_V(8); G8_WAIT_L(0); G8_BAR; G8_MMA(0, 0, At, B0); G8_MMA(0, 1, At, B1); G8_BAR; G8_SCHED;
            G8_LDA(At, 1, 1); G8_STAGE_B(G8_SB(1, 0), b3); G8_STAGE_B(G8_SB(1, 1), b3 + hstep); G8_STAGE_A(G8_SA(1, 0), a2_00, a2_01, k3);
            G8_WAIT_V(8); G8_WAIT_L(0); G8_BAR; G8_MMA(1, 0, At, B0); G8_MMA(1, 1, At, B1); G8_BAR; G8_SCHED;
        }
        if (wr == 0) G8_BAR;
        E(acc, cur, wr, wc, fr, fq);
        if (!has_next) break;
#pragma unroll
        for (int a = 0; a < 2; ++a)
#pragma unroll
            for (int b = 0; b < 2; ++b)
#pragma unroll
                for (int m = 0; m < 4; ++m)
#pragma unroll
                    for (int n = 0; n < 2; ++n) acc[a][b][m][n] = (f32x4){0.f, 0.f, 0.f, 0.f};
        cur = nxt; cB = nB; ++ui;
#pragma unroll
        for (int h = 0; h < 2; ++h)
#pragma unroll
            for (int i = 0; i < 2; ++i) oc[h][i] = on[h][i];
        if (wr == 1) G8_BAR;
    }
    G8_WAIT_V(0);
    G8_BAR;
#undef G8_SA
#undef G8_SB
#undef G8_STAGE_A
#undef G8_STAGE_B
#undef G8_LDA
#undef G8_LDB
#undef G8_MMA
#undef G8_WAIT_V
#undef G8_WAIT_L
#undef G8_BAR
#undef G8_SCHED
}
template <int W>
DI void pool_build(LAS unsigned char* lds, const bf16_t* z, int mt, int g) {
    const int tid = threadIdx.x, ch16 = tid & 15, r0 = (tid >> 4) * 8;
    const int t0 = mt * 256 + r0, s0 = t0 & (SEQ - 1);
    const bf16_t* up = z + (size_t)t0 * ZLD + 1536 + g * 128 + ch16 * 8;
    u32x4 rows[W + 7];
#pragma unroll
    for (int j = 0; j < W + 7; ++j) {
        const int d = j - (W - 1);
        rows[j] = (s0 + d >= 0) ? *(const u32x4*)(up + (ptrdiff_t)d * ZLD) : (u32x4){0u, 0u, 0u, 0u};
    }
    float a8[8];
#pragma unroll
    for (int q = 0; q < 8; ++q) a8[q] = 0.f;
#pragma unroll
    for (int j = 0; j < W - 1; ++j) { const u32x4 v = rows[j];
        a8[0] += bflo(v.x); a8[1] += bfhi(v.x); a8[2] += bflo(v.y); a8[3] += bfhi(v.y); a8[4] += bflo(v.z); a8[5] += bfhi(v.z); a8[6] += bflo(v.w); a8[7] += bfhi(v.w); }
#pragma unroll
    for (int i = 0; i < 8; ++i) {
        const u32x4 cur = rows[W - 1 + i];
        a8[0] += bflo(cur.x); a8[1] += bfhi(cur.x); a8[2] += bflo(cur.y); a8[3] += bfhi(cur.y); a8[4] += bflo(cur.z); a8[5] += bfhi(cur.z); a8[6] += bflo(cur.w); a8[7] += bfhi(cur.w);
        const int s = s0 + i, row = r0 + i;
        const float rc = 1.0f / (float)((s + 1 < W) ? (s + 1) : W);
        const u32x4 o = {pk2(a8[0] * rc - bflo(cur.x), a8[1] * rc - bfhi(cur.x)), pk2(a8[2] * rc - bflo(cur.y), a8[3] * rc - bfhi(cur.y)),
                         pk2(a8[4] * rc - bflo(cur.z), a8[5] * rc - bfhi(cur.z)), pk2(a8[6] * rc - bflo(cur.w), a8[7] * rc - bfhi(cur.w))};
        *(LAS u32x4*)(lds + (ch16 >> 3) * 49152 + row * 128 + (((ch16 & 7) ^ (row & 7)) << 4)) = o;
        const u32x4 old = rows[i];
        a8[0] -= bflo(old.x); a8[1] -= bfhi(old.x); a8[2] -= bflo(old.y); a8[3] -= bfhi(old.y); a8[4] -= bflo(old.z); a8[5] -= bfhi(old.z); a8[6] -= bflo(old.w); a8[7] -= bfhi(old.w);
    }
}
DI void pool_unit(f32x4 (&acc)[4][4], LAS unsigned char* lds, const bf16_t* z, int mt, int g, const unsigned char* Bb, const unsigned (&boff)[2]) {
    const int tid = threadIdx.x, lane = tid & 63;
    const int wave = __builtin_amdgcn_readfirstlane(tid >> 6), wm = wave >> 1, wn = wave & 1;
    const int fr = lane & 15, fq = lane >> 4;
    const unsigned xk0 = (unsigned)((fq ^ (lane & 7)) << 4), xk1 = (unsigned)(((4 + fq) ^ (lane & 7)) << 4);
    const unsigned ard = (unsigned)(wm * 64 + fr) * 128u, brd = 32768u + (unsigned)(wn * 64 + fr) * 128u;
    const unsigned wbase = (unsigned)wave * 1024u;
    __syncthreads();
#pragma unroll
    for (int st = 0; st < 2; ++st)
#pragma unroll
        for (int i = 0; i < 2; ++i)
            __builtin_amdgcn_global_load_lds((const unsigned*)(Bb + boff[i] + (unsigned)st * 128u), (LAS unsigned*)(lds + st * 49152 + 32768 + wbase + i * 8192), 16, 0, 0);
    if (g == 0) pool_build<2>(lds, z, mt, g); else if (g == 1) pool_build<4>(lds, z, mt, g); else if (g == 2) pool_build<8>(lds, z, mt, g); else pool_build<16>(lds, z, mt, g);
    asm volatile("s_waitcnt vmcnt(0)" ::: "memory");
    __syncthreads();
#pragma unroll
    for (int st = 0; st < 2; ++st) {
        LAS unsigned char* sb = lds + st * 49152;
#pragma unroll
        for (int ks = 0; ks < 2; ++ks) {
            const unsigned xk = ks ? xk1 : xk0;
            bf16x8 af[4], bfr[4];
#pragma unroll
            for (int m = 0; m < 4; ++m) af[m] = *(LAS bf16x8*)(sb + ard + m * 2048 + xk);
#pragma unroll
            for (int n = 0; n < 4; ++n) bfr[n] = *(LAS bf16x8*)(sb + brd + n * 2048 + xk);
#pragma unroll
            for (int m = 0; m < 4; ++m)
#pragma unroll
                for (int n = 0; n < 4; ++n) acc[m][n] = mfma16(bfr[n], af[m], acc[m][n]);
        }
    }
    __syncthreads();
}
DI void zero_acc(f32x4 (&acc)[4][4]) {
#pragma unroll
    for (int m = 0; m < 4; ++m)
#pragma unroll
        for (int n = 0; n < 4; ++n) acc[m][n] = (f32x4){0.f, 0.f, 0.f, 0.f};
}

DI void transpose_load(f32x4 (&v)[8], const float* src, int ldn, int k0, int n0) {
    const int tid = threadIdx.x, lk = tid >> 6, ln4 = (tid & 63) * 4;
#pragma unroll
    for (int i = 0; i < 8; ++i) v[i] = *(const f32x4*)(src + (size_t)(k0 + lk + 8 * i) * ldn + n0 + ln4);
}
DI void transpose_finish(const f32x4 (&v)[8], int K, bf16_t* dst, int k0, int n0, const float* gk, int mode, LAS float* t) {
    const int tid = threadIdx.x;
    const int lk = tid >> 6, ln4 = (tid & 63) * 4;
#pragma unroll
    for (int i = 0; i < 8; ++i) { LAS float* p = t + (lk + 8 * i) * 257 + ln4; p[0] = v[i].x; p[1] = v[i].y; p[2] = v[i].z; p[3] = v[i].w; }
    __syncthreads();
    const int c = tid & 7, nn = tid >> 3;
    float g[8];
#pragma unroll
    for (int j = 0; j < 8; ++j) g[j] = gk ? gk[k0 + c * 8 + j] : 1.0f;
#pragma unroll
    for (int i = 0; i < 4; ++i) {
        const int n = nn + 64 * i;
        float e[8];
#pragma unroll
        for (int j = 0; j < 8; ++j) e[j] = t[(c * 8 + j) * 257 + n] * g[j];
        const int f = n0 + n;
        const int drow = (mode == 0) ? f : ((f >> 7) * 256 + (mode == 2 ? 128 : 0) + (f & 127));
        const u32x4 o = {pk2(e[0], e[1]), pk2(e[2], e[3]), pk2(e[4], e[5]), pk2(e[6], e[7])};
        *(u32x4*)(dst + (size_t)drow * K + k0 + c * 8) = o;
    }
    __syncthreads();
}
DI void transpose_tile(const float* src, int ldn, int K, bf16_t* dst, int k0, int n0, const float* gk, int mode, LAS float* t) {
    f32x4 v[8];
    transpose_load(v, src, ldn, k0, n0);
    transpose_finish(v, K, dst, k0, n0, gk, mode, t);
}

DI void glds16_asm(const void* gsrc, unsigned lds_dst) {
    unsigned keep;
    asm volatile("s_mov_b32 %0, m0\n\ts_mov_b32 m0, %2\n\ts_nop 0\n\tglobal_load_lds_dwordx4 %1, off\n\ts_mov_b32 m0, %0" : "=&s"(keep) : "v"(gsrc), "s"(lds_dst) : "memory");
}
DI void attn_stage_kv(LAS unsigned char* buf, const bf16_t* z, int tok0, int hd) {
    const int tid = threadIdx.x, lane = tid & 63, wave = __builtin_amdgcn_readfirstlane(tid >> 6);
    const int kchunk = (lane & 7) ^ ((((wave & 1) << 2) + (lane >> 4)) & 7);
    const int vchunk = (lane & 7) ^ (((lane >> 4) & 1) << 2);
    const unsigned b0 = (unsigned)__builtin_amdgcn_readfirstlane((int)(unsigned)(size_t)buf) + (unsigned)wave * 1024u;
#pragma unroll
    for (int i = 0; i < 4; ++i) {
        const bf16_t* rowp = z + (size_t)(tok0 + wave * 8 + (lane >> 3) + 64 * i) * ZLD + hd * 64;
        glds16_asm(rowp + 512 + kchunk * 8, b0 + 8192u * i);
        glds16_asm(rowp + 1024 + vchunk * 8, b0 + 32768u + 8192u * i);
    }
}
DI int crow(int i, int h) { return (i & 3) + 8 * (i >> 2) + 4 * h; }

#ifndef ATTN_STUB
#define ATTN_STUB 0
#endif
#define SBAR() __builtin_amdgcn_sched_barrier(0)
#define PIN(x) asm volatile("" : "+v"(x))
#define MX3(a, b, c) __builtin_fmaxf(__builtin_fmaxf((a), (b)), (c))
constexpr float ATT_THR = 8.0f;
DI int wave_min_i32(int v) {
#define DPPMIN(ctrl, rmask) { const int t_ = __builtin_amdgcn_update_dpp(v, v, ctrl, rmask, 0xf, false); v = t_ < v ? t_ : v; }
    DPPMIN(0x111, 0xf) DPPMIN(0x112, 0xf) DPPMIN(0x114, 0xf) DPPMIN(0x118, 0xf) DPPMIN(0x142, 0xa) DPPMIN(0x143, 0xc)
#undef DPPMIN
    return __builtin_amdgcn_readlane(v, 63);
}
DI float xhalf_max(float v) { const auto rr = __builtin_amdgcn_permlane32_swap(__float_as_uint(v), __float_as_uint(v), false, false); return __builtin_fmaxf(__uint_as_float(rr[0]), __uint_as_float(rr[1])); }
DI float xhalf_sum(float v) { const auto rr = __builtin_amdgcn_permlane32_swap(__float_as_uint(v), __float_as_uint(v), false, false); return __uint_as_float(rr[0]) + __uint_as_float(rr[1]); }
template <bool FULL, int STUB>
DI void attn_unit(LAS unsigned char* lds, const bf16x8 (&qf)[4], int dbase, int dlo, int n, const LAS float* tbr, float& m_out, float& l_out, f32x16 (&o)[2]) {
    const int lane = threadIdx.x & 63, r31 = lane & 31, hh = lane >> 5;
    const int tq = (lane & 15) >> 2, tp = lane & 3, tblk = (lane >> 4) & 1;
    if (STUB == 2) { m_out = 0.f; l_out = 1.f;
#pragma unroll
        for (int i = 0; i < 16; ++i) { o[0][i] = qf[0][0]; o[1][i] = qf[1][0]; }
        return; }
    const unsigned kxor = (unsigned)((r31 >> 1) & 7);
    const unsigned vxr = (unsigned)(((tq >> 1) & 1) << 6);
    LAS unsigned char* const vp0 = lds + 32768u + (unsigned)(4 * hh + tq) * 128u + (vxr + 32u * tblk + 8u * tp);
    LAS unsigned char* const vp1 = lds + 32768u + (unsigned)(4 * hh + tq) * 128u + ((64u ^ vxr) + 32u * tblk + 8u * tp);
    LAS unsigned char* kp[4];
#pragma unroll
    for (int s2 = 0; s2 < 4; ++s2) kp[s2] = lds + r31 * 128 + ((((unsigned)(2 * s2 + hh)) ^ kxor) << 4);
    bf16x8 kf[4], vf[4]; u32x4 pw0, pw1; f32x16 sA, sB, cinit;
    float mref = 0.f, ls0 = 0.f, ls1 = 0.f, rm, a_, b_;
#pragma unroll
    for (int i = 0; i < 16; ++i) { o[0][i] = 0.f; o[1][i] = 0.f; }
#define TCL(t) (FULL ? (t) : ((t) < 7 ? (t) : 7))
#define KLD(s2, t) kf[s2] = *(LAS bf16x8*)(kp[s2] + (t) * 4096)
#define VLD(j, t) do { LAS unsigned char* p_ = (((j) & 1) ? vp1 : vp0) + (t) * 4096 + ((j) >> 1) * 2048; \
        const s16x4 a0_ = __builtin_amdgcn_ds_read_tr16_b64_v4i16((LAS s16x4*)p_), a1_ = __builtin_amdgcn_ds_read_tr16_b64_v4i16((LAS s16x4*)(p_ + 1024)); \
        vf[j] = __builtin_shufflevector(a0_, a1_, 0, 1, 2, 3, 4, 5, 6, 7); } while (0)
#define BIAS(S, t) do { if (dlo - ((t) * 32 + 31) < 128) { int d0_ = dbase - 4 * hh - (t) * 32; d0_ = d0_ > 255 ? 255 : d0_; const LAS float* bp_ = tbr + (255 - d0_); \
        _Pragma("unroll") for (int i = 0; i < 16; ++i) S[i] += bp_[crow(i, 0)]; } } while (0)
#define ROWMAX_TAIL() do { rm = xhalf_max(__builtin_fmaxf(a_, b_)); } while (0)
#define MOVE_REF(S, dl_, FIRST) do { const float dl = (dl_); mref += dl; \
        if (!(FIRST)) { const float f_ = fast_exp2(-dl); ls0 *= f_; ls1 *= f_; _Pragma("unroll") for (int i = 0; i < 16; ++i) { o[0][i] *= f_; o[1][i] *= f_; } } \
        _Pragma("unroll") for (int i = 0; i < 16; ++i) { S[i] -= dl; cinit[i] = -mref; } } while (0)
#define PART1(S) do { SBAR(); \
        o[0] = mfma32(vf[0], __builtin_bit_cast(bf16x8, pw0), o[0]); a_ = MX3(S[0], S[1], S[2]); b_ = MX3(S[3], S[4], S[5]); PIN(a_); PIN(b_); SBAR(); \
        o[1] = mfma32(vf[1], __builtin_bit_cast(bf16x8, pw0), o[1]); a_ = MX3(a_, S[6], S[7]); b_ = MX3(b_, S[8], S[9]); PIN(a_); PIN(b_); SBAR(); \
        o[0] = mfma32(vf[2], __builtin_bit_cast(bf16x8, pw1), o[0]); a_ = MX3(a_, S[10], S[11]); b_ = MX3(b_, S[12], S[13]); PIN(a_); PIN(b_); SBAR(); \
        o[1] = mfma32(vf[3], __builtin_bit_cast(bf16x8, pw1), o[1]); a_ = MX3(a_, S[14], S[15]); ROWMAX_TAIL(); PIN(rm); SBAR(); } while (0)
#define GAP2(S, SN, t, s2, PW, w0, CIN) do { \
        if (!FULL || (t) < 7) SN = mfma32(kf[s2], qf[s2], CIN); \
        VLD(s2, t); \
        S[4 * (s2)] = fast_exp2(S[4 * (s2)]); S[4 * (s2) + 1] = fast_exp2(S[4 * (s2) + 1]); S[4 * (s2) + 2] = fast_exp2(S[4 * (s2) + 2]); S[4 * (s2) + 3] = fast_exp2(S[4 * (s2) + 3]); \
        ls0 += S[4 * (s2)]; ls1 += S[4 * (s2) + 1]; ls0 += S[4 * (s2) + 2]; ls1 += S[4 * (s2) + 3]; \
        PW[w0] = pk2(S[4 * (s2)], S[4 * (s2) + 1]); PW[(w0) + 1] = pk2(S[4 * (s2) + 2], S[4 * (s2) + 3]); \
        if (!FULL || (t) < 6) KLD(s2, TCL((t) + 2)); \
        PIN(PW); PIN(ls0); PIN(ls1); SBAR(); } while (0)
#define PART2(S, SN, t) do { GAP2(S, SN, t, 0, pw0, 0, cinit); GAP2(S, SN, t, 1, pw0, 2, SN); GAP2(S, SN, t, 2, pw1, 0, SN); GAP2(S, SN, t, 3, pw1, 2, SN); } while (0)
#define STEP(S, SN, t) do { BIAS(S, t); PART1(S); \
        if (__builtin_expect(__any(rm > ATT_THR), 0)) MOVE_REF(S, __builtin_fmaxf(rm, 0.f), false); \
        PART2(S, SN, t); } while (0)
#pragma unroll
    for (int s2 = 0; s2 < 4; ++s2) KLD(s2, 0);
    sA = mfma32(kf[0], qf[0], (f32x16){0.f, 0.f, 0.f, 0.f, 0.f, 0.f, 0.f, 0.f, 0.f, 0.f, 0.f, 0.f, 0.f, 0.f, 0.f, 0.f});
    sA = mfma32(kf[1], qf[1], sA); sA = mfma32(kf[2], qf[2], sA); sA = mfma32(kf[3], qf[3], sA);
    SBAR();
#pragma unroll
    for (int s2 = 0; s2 < 4; ++s2) KLD(s2, 1);
    BIAS(sA, 0);
    a_ = MX3(sA[0], sA[1], sA[2]); b_ = MX3(sA[3], sA[4], sA[5]); a_ = MX3(a_, sA[6], sA[7]); b_ = MX3(b_, sA[8], sA[9]);
    a_ = MX3(a_, sA[10], sA[11]); b_ = MX3(b_, sA[12], sA[13]); a_ = MX3(a_, sA[14], sA[15]); ROWMAX_TAIL();
    MOVE_REF(sA, rm, true);
    SBAR();
    PART2(sA, sB, 0);
    if (FULL) { STEP(sB, sA, 1); STEP(sA, sB, 2); STEP(sB, sA, 3); STEP(sA, sB, 4); STEP(sB, sA, 5); STEP(sA, sB, 6); STEP(sB, sA, 7); }
    else {
        int t = 1;
#pragma unroll 1
        for (; t + 1 < n; t += 2) { STEP(sB, sA, t); STEP(sA, sB, t + 1); }
        if (t < n) STEP(sB, sA, t);
    }
    SBAR();
    o[0] = mfma32(vf[0], __builtin_bit_cast(bf16x8, pw0), o[0]); o[1] = mfma32(vf[1], __builtin_bit_cast(bf16x8, pw0), o[1]);
    o[0] = mfma32(vf[2], __builtin_bit_cast(bf16x8, pw1), o[0]); o[1] = mfma32(vf[3], __builtin_bit_cast(bf16x8, pw1), o[1]);
    m_out = mref; l_out = xhalf_sum(ls0 + ls1);
#undef TCL
#undef KLD
#undef VLD
#undef BIAS
#undef ROWMAX_TAIL
#undef MOVE_REF
#undef PART1
#undef GAP2
#undef PART2
#undef STEP
}

DI int xcd_remap(int L, int nwg) { const int q = nwg / 8, r = nwg % 8, xcd = L % 8, off = L / 8; return (xcd < r ? xcd * (q + 1) : r * (q + 1) + (xcd - r) * q) + off; }
struct SchedDense {
    int nM, nN, G, c, K; const unsigned char* Bt;
    DI bool next(int i, GUnit& u) const {
        const int nwg = nM * nN; const int L = i * G + c; if (L >= nwg) return false;
        const int wgid = xcd_remap(L, nwg);
        const int nig = 8 * nN, gid = wgid / nig, fm = gid * 8, gsz = (nM - fm) < 8 ? (nM - fm) : 8;
        u.pm = fm + ((wgid % nig) % gsz); u.pn = (wgid % nig) / gsz; u.e = 0; u.cnt = 0;
        u.bptr = Bt + (size_t)u.pn * 256 * K * 2; return true;
    }
    DI void aoffs(const GUnit& u, const int (&R)[2], const int (&C)[2], unsigned (&o)[2][2]) const {
#pragma unroll
        for (int h = 0; h < 2; ++h)
#pragma unroll
            for (int i = 0; i < 2; ++i) o[h][i] = (unsigned)((u.pm * 256 + 128 * h + R[i]) * K + C[i]) * 2u;
    }
};
struct SchedLight {
    int nM, nN, K, first, stride; bool active; const unsigned char* Bt;
    DI bool next(int i, GUnit& u) const {
        const int L = first + i * stride; if (!active || L >= nM * nN) return false;
        u.pm = L / nN; u.pn = L % nN; u.e = 0; u.cnt = 0; u.bptr = Bt + (size_t)u.pn * 256 * K * 2; return true;
    }
    DI void aoffs(const GUnit& u, const int (&R)[2], const int (&C)[2], unsigned (&o)[2][2]) const {
#pragma unroll
        for (int h = 0; h < 2; ++h)
#pragma unroll
            for (int i = 0; i < 2; ++i) o[h][i] = (unsigned)((u.pm * 256 + 128 * h + R[i]) * K + C[i]) * 2u;
    }
};
struct SchedMoe {
    const LAS int* ecnt; const LAS int* epre; const LAS int* ehoff; int G, c, K; const unsigned char* Bt; size_t bstride;
    const unsigned* tok_list; int mode;
    DI bool next(int i, GUnit& u) const {
        const int nwg = epre[32]; const int L = i * G + c; if (L >= nwg) return false;
        const int wgid = xcd_remap(L, nwg);
        int e = 0;
        while (epre[e + 1] <= wgid) ++e;
        const int loc = wgid - epre[e];
        u.e = e; u.cnt = ecnt[e]; u.pm = loc >> 2; u.pn = loc & 3;
        u.bptr = Bt + (size_t)e * bstride + (size_t)u.pn * 256 * K * 2; return true;
    }
    DI void aoffs(const GUnit& u, const int (&R)[2], const int (&C)[2], unsigned (&o)[2][2]) const {
#pragma unroll
        for (int h = 0; h < 2; ++h)
#pragma unroll
            for (int i = 0; i < 2; ++i) {
                int r = u.pm * 256 + 128 * h + R[i]; r = r < u.cnt ? r : u.cnt - 1;
                const unsigned row = mode == 0 ? (tok_list[u.e * 16384 + r] & 0x3FFFu) : (unsigned)(ehoff[u.e] + r);
                o[h][i] = (row * (unsigned)K + (unsigned)C[i]) * 2u;
            }
    }
};
#define EPI_LOOP_BEGIN \
    _Pragma("unroll") for (int ai = 0; ai < 2; ++ai) _Pragma("unroll") for (int m = 0; m < 4; ++m) { const int rl = 128 * ai + 64 * wr + 16 * m + fr;
#define EPI_LOOP_END }
struct EpiZ {
    bf16_t* z; const float* rstd0; float* kmean; LAS float* red;
    DI void operator()(const f32x4 (&acc)[2][2][4][2], const GUnit& u, int wr, int wc, int fr, int fq) const {
        f32x4 cs[2][2];
        const float qsc = u.pn < 2 ? 0.125f * LOG2E : 1.0f;
#pragma unroll
        for (int bj = 0; bj < 2; ++bj)
#pragma unroll
            for (int n = 0; n < 2; ++n) cs[bj][n] = (f32x4){0.f, 0.f, 0.f, 0.f};
        EPI_LOOP_BEGIN
            const int row = u.pm * 256 + rl; const float rs = rstd0[row] * qsc;
#pragma unroll
            for (int bj = 0; bj < 2; ++bj)
#pragma unroll
                for (int n = 0; n < 2; ++n) { const int col = u.pn * 256 + 128 * bj + 32 * wc + 8 * fq + 4 * n; const f32x4 v = acc[ai][bj][m][n] * rs;
                    cs[bj][n] += v;
                    *(u32x2*)(z + (size_t)row * ZLD + col) = (u32x2){pk2(v.x, v.y), pk2(v.z, v.w)}; }
        EPI_LOOP_END
        if (u.pn == 2 || u.pn == 3) {
#pragma unroll
            for (int bj = 0; bj < 2; ++bj)
#pragma unroll
                for (int n = 0; n < 2; ++n)
#pragma unroll
                    for (int q = 0; q < 4; ++q) { float v = cs[bj][n][q]; v += __shfl_xor(v, 1); v += __shfl_xor(v, 2); v += __shfl_xor(v, 4); v += __shfl_xor(v, 8);
                        if (fr == 0) red[wr * 256 + 128 * bj + 32 * wc + 8 * fq + 4 * n + q] = v; }
            asm volatile("s_waitcnt lgkmcnt(0)" ::: "memory"); __builtin_amdgcn_s_barrier(); asm volatile("" ::: "memory");
            const int t = threadIdx.x;
            if (t < 256) { const float sm = red[t] + red[256 + t]; const int col = u.pn * 256 + t - 512;
                kmean[(((u.pm >> 5) * 8 + (col >> 6)) * 32 + (u.pm & 31)) * 64 + (col & 63)] = sm * (1.0f / 256.0f); }
            asm volatile("s_waitcnt lgkmcnt(0)" ::: "memory"); __builtin_amdgcn_s_barrier(); asm volatile("" ::: "memory");
        }
    }
};
struct EpiBf16Plain {
    bf16_t* o; int ld;
    DI void operator()(const f32x4 (&acc)[2][2][4][2], const GUnit& u, int wr, int wc, int fr, int fq) const {
        EPI_LOOP_BEGIN
            const int row = u.pm * 256 + rl;
#pragma unroll
            for (int bj = 0; bj < 2; ++bj)
#pragma unroll
                for (int n = 0; n < 2; ++n) { const int col = u.pn * 256 + 128 * bj + 32 * wc + 8 * fq + 4 * n; const f32x4 v = acc[ai][bj][m][n];
                    *(u32x2*)(o + (size_t)row * ld + col) = (u32x2){pk2(v.x, v.y), pk2(v.z, v.w)}; }
        EPI_LOOP_END
    }
};
struct EpiX1 {
    bf16_t* xb; float* ss; bool dry;
    DI void operator()(const f32x4 (&acc)[2][2][4][2], const GUnit& u, int wr, int wc, int fr, int fq) const {
        EPI_LOOP_BEGIN
            const int row = u.pm * 256 + rl; float sq = 0.f;
#pragma unroll
            for (int bj = 0; bj < 2; ++bj) { const int col = u.pn * 256 + 128 * bj + 32 * wc + 8 * fq;
                u32x4* px = (u32x4*)(xb + (size_t)row * D + col);
                const u32x4 xw = *px;
                const f32x4 v0 = (f32x4){bflo(xw.x), bfhi(xw.x), bflo(xw.y), bfhi(xw.y)} + acc[ai][bj][m][0];
                const f32x4 v1 = (f32x4){bflo(xw.z), bfhi(xw.z), bflo(xw.w), bfhi(xw.w)} + acc[ai][bj][m][1];
                if (!dry) *px = (u32x4){pk2(v0.x, v0.y), pk2(v0.z, v0.w), pk2(v1.x, v1.y), pk2(v1.z, v1.w)};
                sq += ((v0.x * v0.x + v0.y * v0.y) + (v0.z * v0.z + v0.w * v0.w)) + ((v1.x * v1.x + v1.y * v1.y) + (v1.z * v1.z + v1.w * v1.w)); }
            sq += __shfl_xor(sq, 16); sq += __shfl_xor(sq, 32);
            if (fq == 0 && !dry) ss[row * 16 + u.pn * 4 + wc] = sq;
        EPI_LOOP_END
    }
};
struct EpiHid {
    bf16_t* hid; const unsigned* tok_list; const float* gate_list; const float* rstd1; const LAS int* ehoff;
    DI void operator()(const f32x4 (&acc)[2][2][4][2], const GUnit& u, int wr, int wc, int fr, int fq) const {
        EPI_LOOP_BEGIN
            const int r = u.pm * 256 + rl;
            if (r < u.cnt) {
                const unsigned tok = tok_list[u.e * 16384 + r] & 0x3FFFu;
                const float gw = gate_list[u.e * 16384 + r];
                const float rs = rstd1[tok];
                bf16_t* hp = hid + (size_t)(ehoff[u.e] + r) * 512 + u.pn * 128 + 32 * wc + 8 * fq;
                float h8[8];
#pragma unroll
                for (int n = 0; n < 2; ++n) {
                    const f32x4 a = acc[ai][0][m][n] * rs, uu = acc[ai][1][m][n] * rs;
#pragma unroll
                    for (int q = 0; q < 4; ++q) { const float sg = a[q] * fast_rcp(1.0f + __expf(-a[q])); h8[4 * n + q] = sg * uu[q] * gw; }
                }
                *(u32x4*)hp = (u32x4){pk2(h8[0], h8[1]), pk2(h8[2], h8[3]), pk2(h8[4], h8[5]), pk2(h8[6], h8[7])};
            }
        EPI_LOOP_END
    }
};
struct EpiY {
    bf16_t* yslot; const unsigned* tok_list;
    DI void operator()(const f32x4 (&acc)[2][2][4][2], const GUnit& u, int wr, int wc, int fr, int fq) const {
        EPI_LOOP_BEGIN
            const int r = u.pm * 256 + rl;
            if (r < u.cnt) {
                const unsigned ent = tok_list[u.e * 16384 + r]; const unsigned tok = ent & 0x3FFFu, slot = ent >> 14;
                bf16_t* yp = yslot + ((size_t)slot * T + tok) * D;
#pragma unroll
                for (int bj = 0; bj < 2; ++bj)
#pragma unroll
                    for (int n = 0; n < 2; ++n) { const int col = u.pn * 256 + 128 * bj + 32 * wc + 8 * fq + 4 * n; const f32x4 v = acc[ai][bj][m][n];
                        *(u32x2*)(yp + col) = (u32x2){pk2(v.x, v.y), pk2(v.z, v.w)}; }
            }
        EPI_LOOP_END
    }
};
struct EpiX3F {
    const bf16_t* x2; float* out; const bf16_t* pp; const float* rstd2; float* ss; unsigned* pcnt; const float* gfin;
    DI void operator()(f32x4 (&acc)[2][2][4][2], const GUnit& u, int wr, int wc, int fr, int fq) const {
        EPI_LOOP_BEGIN
            const int row = u.pm * 256 + rl; const float rs = rstd2[row]; float sq = 0.f;
#pragma unroll
            for (int bj = 0; bj < 2; ++bj) { const int col = u.pn * 256 + 128 * bj + 32 * wc + 8 * fq;
                const u32x4 xw = *(const u32x4*)(x2 + (size_t)row * D + col);
                const u32x4 pw = *(const u32x4*)(pp + (size_t)row * D + col);
                const float xv[8] = {bflo(xw.x), bfhi(xw.x), bflo(xw.y), bfhi(xw.y), bflo(xw.z), bfhi(xw.z), bflo(xw.w), bfhi(xw.w)};
                const float pv[8] = {bflo(pw.x), bfhi(pw.x), bflo(pw.y), bfhi(pw.y), bflo(pw.z), bfhi(pw.z), bflo(pw.w), bfhi(pw.w)};
#pragma unroll
                for (int n = 0; n < 2; ++n) { f32x4 v;
#pragma unroll
                    for (int q = 0; q < 4; ++q) { const float gt = fast_rcp(1.0f + __expf(-acc[ai][bj][m][n][q] * rs)); v[q] = xv[4 * n + q] + pv[4 * n + q] * gt; }
                    acc[ai][bj][m][n] = v;
                    sq += (v.x * v.x + v.y * v.y) + (v.z * v.z + v.w * v.w); } }
            sq += __shfl_xor(sq, 16); sq += __shfl_xor(sq, 32);
            if (fq == 0) atomicAdd(&ss[row], sq);
        EPI_LOOP_END
        asm volatile("s_waitcnt vmcnt(0)" ::: "memory");
        unsigned* pc = pcnt + 64 * u.pm;
        if ((threadIdx.x & 63) == 0) __hip_atomic_fetch_add(pc, 1u, __ATOMIC_RELAXED, __HIP_MEMORY_SCOPE_AGENT);
        for (unsigned spins = 0; spins < (1u << 22); ++spins) {
            const unsigned c = (unsigned)__builtin_amdgcn_readfirstlane((int)__hip_atomic_load(pc, __ATOMIC_RELAXED, __HIP_MEMORY_SCOPE_AGENT));
            if (c >= 32u) break;
            __builtin_amdgcn_s_sleep(2);
        }
        EPI_LOOP_BEGIN
            const int row = u.pm * 256 + rl;
            const float r3 = rsqrtf(__hip_atomic_load(&ss[row], __ATOMIC_RELAXED, __HIP_MEMORY_SCOPE_AGENT) * (1.0f / D) + EPS);
#pragma unroll
            for (int bj = 0; bj < 2; ++bj)
#pragma unroll
                for (int n = 0; n < 2; ++n) { const int col = u.pn * 256 + 128 * bj + 32 * wc + 8 * fq + 4 * n;
                    const f32x4 g4 = *(const f32x4*)(gfin + col);
                    *(f32x4*)(out + (size_t)row * D + col) = acc[ai][bj][m][n] * r3 * g4; }
        EPI_LOOP_END
    }
};
struct EpiX3 {
    const bf16_t* x2; float* out; const bf16_t* pp; const float* rstd2; float* ss; bool dry;
    DI void operator()(const f32x4 (&acc)[2][2][4][2], const GUnit& u, int wr, int wc, int fr, int fq) const {
        EPI_LOOP_BEGIN
            const int row = u.pm * 256 + rl; const float rs = rstd2[row]; float sq = 0.f;
#pragma unroll
            for (int bj = 0; bj < 2; ++bj)
#pragma unroll
                for (int n = 0; n < 2; ++n) { const int col = u.pn * 256 + 128 * bj + 32 * wc + 8 * fq + 4 * n;
                    const u32x2 xw = *(const u32x2*)(x2 + (size_t)row * D + col);
                    f32x4 v = {bflo(xw.x), bfhi(xw.x), bflo(xw.y), bfhi(xw.y)};
                    const u32x2 pw = *(const u32x2*)(pp + (size_t)row * D + col);
                    const float p4[4] = {bflo(pw.x), bfhi(pw.x), bflo(pw.y), bfhi(pw.y)};
#pragma unroll
                    for (int q = 0; q < 4; ++q) { const float gt = fast_rcp(1.0f + __expf(-acc[ai][bj][m][n][q] * rs)); v[q] += p4[q] * gt; }
                    if (!dry) *(f32x4*)(out + (size_t)row * D + col) = v;
                    sq += (v.x * v.x + v.y * v.y) + (v.z * v.z + v.w * v.w); }
            sq += __shfl_xor(sq, 16); sq += __shfl_xor(sq, 32);
            if (fq == 0 && !dry) atomicAdd(&ss[row], sq);
        EPI_LOOP_END
    }
};

DI const void* karg_ptr(int byte_off) {
    unsigned long long p;
    asm volatile("s_load_dwordx2 %0, %1, %2\n\ts_waitcnt lgkmcnt(0)" : "=s"(p) : "s"(__builtin_amdgcn_kernarg_segment_ptr()), "i"(byte_off) : "memory");
    return (const void*)(const __attribute__((address_space(1))) void*)p;
}
struct Params {
    const float* in[20];
    float* out;
    unsigned char* ws;
    int dry, pad;
};

template <unsigned MASK, bool HASDRY>
__global__ void __launch_bounds__(NT, 2) hymba_fwd(Params P) {
    extern __shared__ __attribute__((aligned(16))) unsigned char smem_raw[];
    LAS unsigned char* lds = (LAS unsigned char*)smem_raw;
    const int tid = threadIdx.x, lane = tid & 63;
    const int wave = __builtin_amdgcn_readfirstlane(tid >> 6);
    const int G = gridDim.x;
    const int vcu = (G % 8 == 0) ? ((int)(blockIdx.x % 8) * (G / 8) + (int)(blockIdx.x / 8)) : (int)blockIdx.x;
    unsigned char* ws = (unsigned char*)karg_ptr(168);

    volatile LAS unsigned* misc = (volatile LAS unsigned*)(lds + LDS_MISC);
    if (tid < 4) misc[tid] = 0u;
    __syncthreads();
    const bool dry = HASDRY ? (P.dry != 0) : false; (void)dry;
    XcdBarrier bar; bar.bar = (unsigned*)(ws + WS_CTL); bar.x = 0; bar.st = misc;
    if (!HASDRY) bar = xcd_barrier_post((unsigned*)(ws + WS_CTL), misc);
    LAS int* marr = (LAS int*)(lds + LDS_MISC + MISC_ARR);

    const float* x;
    const float* pin;
    const float* g_mix;
    const float* w_in;
    const float* w_pool;
    const float* pool_scale;
    const float* w_out;
    const float* rel_bias;
    const float* g_ffn;
    const float* w_r1;
    const float* b_r1;
    const float* w_r2;
    const float* b_r2;
    const float* w_gate;
    const float* w_up;
    const float* w_down;
    const float* g_ple;
    const float* w_ple;
    const float* w_pg;
    const float* g_final;
    float* out;
    unsigned* cnt_sel;
    unsigned* cnt_exp;
    float* ss1;
    float* ss3;
    float* kmean;
    float* tab;
    float* rstd0;
    float* rstd2;
    float* routeb;
    bf16_t* WinT;
    bf16_t* WoutT;
    bf16_t* WpgT;
    bf16_t* WpleT;
    bf16_t* WpoolT;
    bf16_t* WrT;
    bf16_t* xb;
    bf16_t* z;
    bf16_t* WguT;
    bf16_t* yslot;
    unsigned* tok_list;
    float* gate_list;
    unsigned* sel_list;
    bf16_t* part_o;
    bf16_t* WdT;
    float* part_ml;
    bf16_t* ab;
    bf16_t* hid;
    bf16_t* pb;
    bf16_t* ppb;
    {
        unsigned char* wsl = (unsigned char*)karg_ptr(168);
        x = (const float*)karg_ptr(8 * 0);
        pin = (const float*)karg_ptr(8 * 1);
        g_mix = (const float*)karg_ptr(8 * 2);
        w_in = (const float*)karg_ptr(8 * 3);
        w_pool = (const float*)karg_ptr(8 * 4);
        pool_scale = (const float*)karg_ptr(8 * 5);
        w_out = (const float*)karg_ptr(8 * 6);
        rel_bias = (const float*)karg_ptr(8 * 7);
        w_r1 = (const float*)karg_ptr(8 * 9);
        b_r1 = (const float*)karg_ptr(8 * 10);
        w_r2 = (const float*)karg_ptr(8 * 11);
        b_r2 = (const float*)karg_ptr(8 * 12);
        g_ple = (const float*)karg_ptr(8 * 16);
        w_ple = (const float*)karg_ptr(8 * 17);
        w_pg = (const float*)karg_ptr(8 * 18);
        tab = (float*)(wsl + WS_TAB);
        rstd0 = (float*)(wsl + WS_RSTD0);
        routeb = (float*)(wsl + WS_RB);
        WinT = (bf16_t*)(wsl + WS_WIN);
        WoutT = (bf16_t*)(wsl + WS_WOUT);
        WpgT = (bf16_t*)(wsl + WS_WPG);
        WpleT = (bf16_t*)(wsl + WS_WPLE);
        WpoolT = (bf16_t*)(wsl + WS_WPOOL);
        WrT = (bf16_t*)(wsl + WS_WR);
        xb = (bf16_t*)(wsl + WS_XB);
        z = (bf16_t*)(wsl + WS_Z);
        pb = (bf16_t*)(wsl + WS_PB);
        g_ffn = (const float*)karg_ptr(8 * 8);
    }

    const int srow = tid >> 3, sc = (tid & 7) ^ (srow & 7);
    const int wm = wave >> 1, wn = wave & 1, fr = lane & 15, fq = lane >> 4;
    const int r31 = lane & 31, hh = lane >> 5;

    if constexpr (PH(0)) {
    {
        for (int i = vcu * NT + tid; i < 65536 + 49152 + 1056 + 48; i += G * NT) {
            if (i < 65536) {
                const int g = i >> 14, n = (i >> 7) & 127, k = i & 127;
                WpoolT[i] = (bf16_t)(pk2(w_pool[(g * 128 + k) * 128 + n] * pool_scale[g * 128 + n], 0.f) & 0xffffu);
            } else if (i < 65536 + 49152) {
                const int j = i - 65536, n = j >> 10, k = j & 1023;
                float v = 0.f;
                if (n < 4) v = w_r1[k * 4 + n] * g_ffn[k];
                else if (n < 36) { const int gg = (n - 4) >> 3, e = (n - 4) & 7; v = w_r2[(gg * 1024 + k) * 8 + e] * g_ffn[k]; }
                WrT[j] = (bf16_t)(pk2(v, 0.f) & 0xffffu);
            } else if (i < 65536 + 49152 + 1056) {
                const int j = i - 65536 - 49152, h = j / 132, d = j % 132;
                int bk;
                if (d < 16) bk = d;
                else { bk = 16 + (int)(logf((float)d / 16.0f) / logf(8.0f) * 16.0f); bk = bk > 31 ? 31 : bk; }
                tab[j] = rel_bias[bk * 8 + h] * LOG2E;
            } else {
                const int j = i - 65536 - 49152 - 1056;
                routeb[j] = j < 4 ? b_r1[j] : (j < 36 ? b_r2[j - 4] : 0.f);
            }
        }
        LAS float* tl = (LAS float*)lds;
        for (int it = vcu; it < 272; it += G) {
            int r = it;
            if (r < 128) { transpose_tile(w_in, 2048, 1024, WinT, (r >> 3) * 64, (r & 7) * 256, g_mix, 0, tl); continue; } r -= 128;
            if (r < 64)  { transpose_tile(w_out, 1024, 1024, WoutT, (r >> 2) * 64, (r & 3) * 256, nullptr, 0, tl); continue; } r -= 64;
            if (r < 64)  { transpose_tile(w_pg, 1024, 1024, WpgT, (r >> 2) * 64, (r & 3) * 256, g_ple, 0, tl); continue; } r -= 64;
            transpose_tile(w_ple, 1024, 256, WpleT, (r >> 2) * 64, (r & 3) * 256, nullptr, 0, tl);
        }
        for (int i = vcu * NT + tid; i < T * 256 / 8; i += G * NT) {
            const f32x4 v0 = ((const f32x4*)pin)[2 * i], v1 = ((const f32x4*)pin)[2 * i + 1];
            ((u32x4*)pb)[i] = (u32x4){pk2(v0.x, v0.y), pk2(v0.z, v0.w), pk2(v1.x, v1.y), pk2(v1.z, v1.w)};
        }
        for (int row = (vcu * 8 + wave) * 2; row < T; row += G * 16) {
            const f32x4* xr = (const f32x4*)(x + (size_t)row * D) + lane;
            f32x4 v[8]; float s0 = 0.f, s1 = 0.f;
#pragma unroll
            for (int j = 0; j < 8; ++j) v[j] = xr[64 * j];
#pragma unroll
            for (int j = 0; j < 4; ++j) { s0 += (v[j].x * v[j].x + v[j].y * v[j].y) + (v[j].z * v[j].z + v[j].w * v[j].w);
                                          s1 += (v[4 + j].x * v[4 + j].x + v[4 + j].y * v[4 + j].y) + (v[4 + j].z * v[4 + j].z + v[4 + j].w * v[4 + j].w); }
            s0 = wave_sum(s0); s1 = wave_sum(s1);
            u32x2* o = (u32x2*)(xb + (size_t)row * D) + lane;
#pragma unroll
            for (int j = 0; j < 8; ++j) o[64 * j] = (u32x2){pk2(v[j].x, v[j].y), pk2(v[j].z, v[j].w)};
            if (lane == 0) { rstd0[row] = rsqrtf(s0 * (1.0f / D) + EPS); rstd0[row + 1] = rsqrtf(s1 * (1.0f / D) + EPS); }
        }
    }
    }
    if constexpr (!HASDRY) xcd_barrier(bar);
    {
        unsigned char* wsl = (unsigned char*)karg_ptr(168);
        x = (const float*)karg_ptr(8 * 0);
        rstd0 = (float*)(wsl + WS_RSTD0);
        WinT = (bf16_t*)(wsl + WS_WIN);
        xb = (bf16_t*)(wsl + WS_XB);
        z = (bf16_t*)(wsl + WS_Z);
        kmean = (float*)(wsl + WS_KMEAN);
    }

    if constexpr (PH(1)) {
    {
        SchedDense S1{64, 8, G, (int)blockIdx.x, 1024, (const unsigned char*)WinT};
        gemm8(lds, (const unsigned char*)xb, 1024, S1, EpiZ{z, rstd0, kmean, (LAS float*)(lds + LDS_MISC + 10240)});
    }
    }
    if constexpr (!HASDRY) xcd_barrier(bar);
    {
        unsigned char* wsl = (unsigned char*)karg_ptr(168);
        x = (const float*)karg_ptr(8 * 0);
        kmean = (float*)(wsl + WS_KMEAN);
        WpleT = (bf16_t*)(wsl + WS_WPLE);
        z = (bf16_t*)(wsl + WS_Z);
        pb = (bf16_t*)(wsl + WS_PB);
        ppb = (bf16_t*)(wsl + WS_PP);
    }

    {
        unsigned char* wsl = (unsigned char*)karg_ptr(168);
        x = (const float*)karg_ptr(8 * 0);
        cnt_sel = (unsigned*)(wsl + OFF_CNT_SEL);
        kmean = (float*)(wsl + WS_KMEAN);
        WpoolT = (bf16_t*)(wsl + WS_WPOOL);
        z = (bf16_t*)(wsl + WS_Z);
        sel_list = (unsigned*)(wsl + WS_SEL);
        ab = (bf16_t*)(wsl + WS_AB);
    }

    if constexpr (PH(3)) {
    {
        LAS unsigned char* kmh = lds;
        LAS unsigned char* kml = lds + 4096;
        LAS unsigned* hist = (LAS unsigned*)marr;
        for (int u = vcu; u < 256; u += G) {
            const int bh = u >> 4, ck = u & 15, b = bh >> 3, hd = bh & 7;
            const int s = ck * 512 + tid, ob = s >> 8;
            __syncthreads();
            {
                const int j = tid >> 4, d0 = (tid & 15) * 4;
                const f32x4 kv = *(const f32x4*)(kmean + (size_t)bh * 2048 + tid * 4);
                const unsigned h0 = pk2(kv.x, kv.y), h1 = pk2(kv.z, kv.w);
                const unsigned l0 = pk2(kv.x - bflo(h0), kv.y - bfhi(h0)), l1 = pk2(kv.z - bflo(h1), kv.w - bfhi(h1));
                const unsigned off = (unsigned)j * 128u + ((((unsigned)(d0 >> 3)) ^ (((unsigned)j >> 1) & 7u)) << 4) + (unsigned)(d0 & 7) * 2u;
                *(LAS u32x2*)(kmh + off) = (u32x2){h0, h1};
                *(LAS u32x2*)(kml + off) = (u32x2){l0, l1};
            }
            if (tid < 32) hist[tid] = 0u;
            bf16x8 qg[2][4];
#pragma unroll
            for (int t2 = 0; t2 < 2; ++t2) {
                const bf16_t* qp = z + (size_t)(b * SEQ + ck * 512 + wave * 64 + t2 * 32 + r31) * ZLD + hd * 64 + 8 * hh;
#pragma unroll
                for (int s2 = 0; s2 < 4; ++s2) qg[t2][s2] = *(const bf16x8*)(qp + 16 * s2);
            }
            __syncthreads();
            float v0 = -INFINITY, v1 = -INFINITY, v2 = -INFINITY; int i0 = 0, i1 = 0, i2 = 0;
#pragma unroll
            for (int t2 = 0; t2 < 2; ++t2) {
                f32x16 g16;
#pragma unroll
                for (int i = 0; i < 16; ++i) g16[i] = 0.f;
#pragma unroll
                for (int s2 = 0; s2 < 4; ++s2) {
                    const unsigned ko = (unsigned)r31 * 128u + ((((unsigned)(2 * s2 + hh)) ^ (((unsigned)r31 >> 1) & 7u)) << 4);
                    g16 = mfma32(*(LAS bf16x8*)(kmh + ko), qg[t2][s2], g16);
                    g16 = mfma32(*(LAS bf16x8*)(kml + ko), qg[t2][s2], g16);
                }
                float a0 = -INFINITY, a1 = -INFINITY, a2 = -INFINITY; int j0 = 64, j1 = 64, j2 = 64;
#pragma unroll
                for (int i = 0; i < 16; ++i) {
                    const int j = crow(i, hh); const float gv = (j < ob) ? g16[i] : -INFINITY;
                    if (gv > a2) {
                        if (gv > a1) { a2 = a1; j2 = j1; if (gv > a0) { a1 = a0; j1 = j0; a0 = gv; j0 = j; } else { a1 = gv; j1 = j; } }
                        else { a2 = gv; j2 = j; }
                    }
                }
                float pv[3] = {__shfl_xor(a0, 32), __shfl_xor(a1, 32), __shfl_xor(a2, 32)};
                int pj[3] = {__shfl_xor(j0, 32), __shfl_xor(j1, 32), __shfl_xor(j2, 32)};
#pragma unroll
                for (int k = 0; k < 3; ++k) {
                    const float gv = pv[k]; const int j = pj[k];
                    const bool b2 = gv > a2 || (gv == a2 && j < j2), b1 = gv > a1 || (gv == a1 && j < j1), b0 = gv > a0 || (gv == a0 && j < j0);
                    if (b2) {
                        if (b1) { a2 = a1; j2 = j1; if (b0) { a1 = a0; j1 = j0; a0 = gv; j0 = j; } else { a1 = gv; j1 = j; } }
                        else { a2 = gv; j2 = j; }
                    }
                }
                if (hh == t2) { v0 = a0; v1 = a1; v2 = a2; i0 = j0; i1 = j1; i2 = j2; }
            }
            i0 &= 31; i1 &= 31; i2 &= 31;
            const int nvalid = ob < 3 ? ob : 3;
            unsigned lp0 = 0, lp1 = 0, lp2 = 0;
            if (dry) { if (v0 + v1 + v2 == 12345.f) cnt_sel[0] = (unsigned)(i0 + i1 + i2); continue; }
            if (nvalid > 0) lp0 = atomicAdd((unsigned*)&hist[i0], 1u);
            if (nvalid > 1) lp1 = atomicAdd((unsigned*)&hist[i1], 1u);
            if (nvalid > 2) lp2 = atomicAdd((unsigned*)&hist[i2], 1u);
            __syncthreads();
            if (tid < 32) { const unsigned c = hist[tid]; hist[32 + tid] = c ? atomicAdd(&cnt_sel[bh * 32 + tid], c) : 0u; }
            __syncthreads();
            if (nvalid > 0) sel_list[(size_t)(bh * 32 + i0) * 8192 + hist[32 + i0] + lp0] = (unsigned)s | (0u << 13);
            if (nvalid > 1) sel_list[(size_t)(bh * 32 + i1) * 8192 + hist[32 + i1] + lp1] = (unsigned)s | (1u << 13);
            if (nvalid > 2) sel_list[(size_t)(bh * 32 + i2) * 8192 + hist[32 + i2] + lp2] = (unsigned)s | (2u << 13);
        }
        __syncthreads();
        for (int u = vcu; u < 256; u += G) {
            const int mt = u >> 2, g = u & 3;
            unsigned aoff[4], boff[2];
#pragma unroll
            for (int i = 0; i < 2; ++i) boff[i] = (unsigned)(((g * 128) + srow + 64 * i) * 128 + sc * 8) * 2u;
            f32x4 acc[4][4]; zero_acc(acc);
            pool_unit(acc, lds, z, mt, g, (const unsigned char*)WpoolT, boff);
#pragma unroll
            for (int m = 0; m < 4; ++m) {
                const int row = mt * 256 + wm * 64 + m * 16 + fr;
#pragma unroll
                for (int n = 0; n < 4; ++n) {
                    const int col = 512 + g * 128 + wn * 64 + n * 16 + fq * 4;
                    const f32x4 v = acc[m][n];
                    *(u32x2*)(ab + (size_t)row * D + col) = (u32x2){pk2(v.x, v.y), pk2(v.z, v.w)};
                }
            }
        }
    }
    }
    if constexpr (!HASDRY) xcd_barrier(bar);
    {
        unsigned char* wsl = (unsigned char*)karg_ptr(168);
        cnt_sel = (unsigned*)(wsl + OFF_CNT_SEL);
        tab = (float*)(wsl + WS_TAB);
        z = (bf16_t*)(wsl + WS_Z);
        sel_list = (unsigned*)(wsl + WS_SEL);
        part_o = (bf16_t*)(wsl + WS_PARTO);
        part_ml = (float*)(wsl + WS_PARTML);
    }

    if constexpr (PH(4)) {
    {
        LAS int* pre = marr;
        LAS float* tabl = (LAS float*)(lds + LDS_MISC + MISC_TAB);
        LAS int* desc = (LAS int*)(lds + LDS_MISC + MISC_DESC);
        __syncthreads();
        if (wave == 0) {
            const u32x4 c0 = *(const u32x4*)(cnt_sel + lane * 8), c1 = *(const u32x4*)(cnt_sel + lane * 8 + 4);
            int v[8] = {(int)((c0.x + 255u) >> 8), (int)((c0.y + 255u) >> 8), (int)((c0.z + 255u) >> 8), (int)((c0.w + 255u) >> 8),
                        (int)((c1.x + 255u) >> 8), (int)((c1.y + 255u) >> 8), (int)((c1.z + 255u) >> 8), (int)((c1.w + 255u) >> 8)};
#pragma unroll
            for (int i = 1; i < 8; ++i) v[i] += v[i - 1];
            int tot = v[7];
#pragma unroll
            for (int o2 = 1; o2 < 64; o2 <<= 1) { const int t2 = __shfl_up(tot, o2); if (lane >= o2) tot += t2; }
            const int base = tot - v[7];
            if (lane == 0) pre[0] = 0;
#pragma unroll
            for (int i = 0; i < 8; ++i) pre[lane * 8 + i + 1] = base + v[i];
        }
        __syncthreads();
        const int total = pre[512];
        for (int i = tid; i < 8 * 132; i += NT) { const int h = i / 132; tabl[i] = tab[i] - tab[h * 132 + 128]; }
        LAS float* c31l = (LAS float*)(lds + LDS_MISC + MISC_DESC + 1024);
        LAS float* tbr = (LAS float*)(lds + LDS_MISC + MISC_TBR);
        if (tid < 8) c31l[tid] = tab[tid * 132 + 128];
        const int nun = vcu < total ? (total - vcu + G - 1) / G : 0;
        if (tid < nun && tid < 64) {
            const int u = vcu + tid * G;
            int lo = 0, hi2 = 512;
            while (hi2 - lo > 1) { const int mid = (lo + hi2) >> 1; if (pre[mid] <= u) lo = mid; else hi2 = mid; }
            desc[tid * 4 + 0] = lo; desc[tid * 4 + 1] = u - pre[lo]; desc[tid * 4 + 2] = (int)cnt_sel[lo];
        }
        __syncthreads();
        if (nun > 0) {
            unsigned ent_c, ent_n = 0; bf16x8 qf[4], qn[4];
            {
                const int li = desc[0], cidx = desc[1], n = desc[2];
                const int bh = li >> 5, j = li & 31;
                if (tid < 256) { const int dist = 255 - tid; tbr[tid] = dist >= 128 ? 0.f : tabl[(bh & 7) * 132 + dist]; }
                attn_stage_kv(lds, z, (bh >> 3) * SEQ + j * 256, bh & 7);
                const int qb = cidx * 256 + wave * 32, qi = qb + r31;
                ent_c = sel_list[(size_t)li * 8192 + ((qi < n) ? qi : cidx * 256)];
                const bf16_t* qp = z + (size_t)((bh >> 3) * SEQ + (int)(ent_c & 8191u)) * ZLD + (bh & 7) * 64 + 8 * hh;
#pragma unroll
                for (int s2 = 0; s2 < 4; ++s2) qf[s2] = *(const bf16x8*)(qp + 16 * s2);
                if (nun > 1) { const int li1 = desc[4], c1 = desc[5], n1 = desc[6]; const int q1 = c1 * 256 + wave * 32 + r31;
                    ent_n = sel_list[(size_t)li1 * 8192 + ((q1 < n1) ? q1 : c1 * 256)]; }
            }
            asm volatile("s_waitcnt vmcnt(0)" ::: "memory");
            __builtin_amdgcn_sched_barrier(0);
            asm volatile("" : "+v"(qf[0]), "+v"(qf[1]), "+v"(qf[2]), "+v"(qf[3]), "+v"(ent_c), "+v"(ent_n));
            __builtin_amdgcn_sched_barrier(0);
            for (int k = 0; k < nun; ++k) {
                asm volatile("s_waitcnt lgkmcnt(0)\n\ts_barrier" ::: "memory");
                LAS unsigned char* kvb = lds + (k & 1) * 65536;
                unsigned ent_nn = 0;
#ifndef P4_NOMEM
#define P4_NOMEM 0
#endif
                if (k + 1 < nun && !(HASDRY && P4_NOMEM)) {
                    const int li1 = desc[(k + 1) * 4], bh1 = li1 >> 5, j1 = li1 & 31;
                    const bf16_t* qp = z + (size_t)((bh1 >> 3) * SEQ + (int)(ent_n & 8191u)) * ZLD + (bh1 & 7) * 64 + 8 * hh;
#pragma unroll
                    for (int s2 = 0; s2 < 4; ++s2) qn[s2] = *(const bf16x8*)(qp + 16 * s2);
                    if (k + 2 < nun) { const int li2 = desc[(k + 2) * 4], c2 = desc[(k + 2) * 4 + 1], n2 = desc[(k + 2) * 4 + 2]; const int q2 = c2 * 256 + wave * 32 + r31;
                        ent_nn = sel_list[(size_t)li2 * 8192 + ((q2 < n2) ? q2 : c2 * 256)]; }
                    asm volatile("" ::: "memory");
                    if (tid < 256) { const int dist = 255 - tid; tbr[((k + 1) & 1) * 256 + tid] = dist >= 128 ? 0.f : tabl[(bh1 & 7) * 132 + dist]; }
                    attn_stage_kv(lds + ((k + 1) & 1) * 65536, z, (bh1 >> 3) * SEQ + j1 * 256, bh1 & 7);
                    asm volatile("" ::: "memory");
                }
                const int li = desc[k * 4], cidx = desc[k * 4 + 1], n = desc[k * 4 + 2];
                const int bh = li >> 5, j = li & 31, hd = bh & 7;
                const int qbase = cidx * 256 + wave * 32;
                const bool act = qbase < n;
                float mx = 0.f, l = 1.f; f32x16 o[2];
                if (act) {
                    const int dbase = (int)(ent_c & 8191u) - j * 256;
                    const int dlo = wave_min_i32(dbase);
                    attn_unit<true, HASDRY ? ATTN_STUB : 0>(kvb, qf, dbase, dlo, 8, tbr + (k & 1) * 256, mx, l, o);
                }
                asm volatile("s_waitcnt vmcnt(0)" ::: "memory");
                __builtin_amdgcn_sched_barrier(0);
                asm volatile("" : "+v"(qn[0]), "+v"(qn[1]), "+v"(qn[2]), "+v"(qn[3]), "+v"(ent_nn));
                __builtin_amdgcn_sched_barrier(0);
                if (act) {
                    {
                        const bool valid = qbase + r31 < n;
                        const int sq = (int)(ent_c & 8191u), rank = (int)(ent_c >> 13);
                        const float inv = fast_rcp(l);
                        const unsigned pidx = valid ? (unsigned)(((size_t)bh * SEQ + sq) * 3 + rank) : 0xFFFFFFFFu;
                        LAS unsigned char* stg = lds + LDS_MISC + MISC_STG + wave * 2560;
#pragma unroll
                        for (int c = 0; c < 2; ++c) {
#pragma unroll
                            for (int g = 0; g < 4; ++g)
                                *(LAS u32x2*)(stg + r31 * 80 + (8 * g + 4 * hh) * 2) = (u32x2){pk2(o[c][4 * g] * inv, o[c][4 * g + 1] * inv), pk2(o[c][4 * g + 2] * inv, o[c][4 * g + 3] * inv)};
                            asm volatile("s_waitcnt lgkmcnt(0)" ::: "memory");
#pragma unroll
                            for (int i = 0; i < 2; ++i) {
                                const int row = i * 16 + (lane >> 2), chunk = lane & 3;
                                const u32x4 v = *(LAS u32x4*)(stg + row * 80 + chunk * 16);
                                const unsigned pr = (unsigned)__shfl((int)pidx, row);
                                if (pr != 0xFFFFFFFFu) *(u32x4*)(part_o + (size_t)pr * 64 + c * 32 + chunk * 8) = v;
                            }
                            asm volatile("s_waitcnt lgkmcnt(0)" ::: "memory");
                        }
                        if (valid && hh == 0) *(f32x2*)(part_ml + (size_t)pidx * 2) = (f32x2){mx + c31l[hd], l};
                    }
                }
                __builtin_amdgcn_sched_barrier(0);
                ent_c = ent_n; ent_n = ent_nn;
#pragma unroll
                for (int s2 = 0; s2 < 4; ++s2) qf[s2] = qn[s2];
            }
        }
        asm volatile("s_waitcnt vmcnt(0)" ::: "memory");
        __syncthreads();
    }
    }
    if constexpr (!HASDRY) xcd_barrier(bar);
    {
        unsigned char* wsl = (unsigned char*)karg_ptr(168);
        x = (const float*)karg_ptr(8 * 0);
        tab = (float*)(wsl + WS_TAB);
        z = (bf16_t*)(wsl + WS_Z);
        part_o = (bf16_t*)(wsl + WS_PARTO);
        part_ml = (float*)(wsl + WS_PARTML);
        ab = (bf16_t*)(wsl + WS_AB);
    }

    if constexpr (PH(5)) {
    {
        LAS float* tabl = (LAS float*)(lds + LDS_MISC + MISC_TAB);
        LAS float* tbr = (LAS float*)(lds + LDS_MISC + MISC_TBR);
        __syncthreads();
        for (int i = tid; i < 8 * 132; i += NT) tabl[i] = tab[i];
        for (int pr = vcu; pr < 256; pr += G) {
            const int half = wave >> 2, wl = wave & 3;
            __syncthreads();
            { const int hdp = ((2 * pr) >> 5) & 7, dist = 255 - tid; tbr[tid] = dist < 0 ? -INFINITY : (dist >= 128 ? 0.f : tabl[hdp * 132 + dist] - tabl[hdp * 132 + 128]); }
            {
                const int uA = 2 * pr, uB = 2 * pr + 1;
                attn_stage_kv(lds, z, ((uA >> 5) >> 3) * SEQ + (uA & 31) * 256, (uA >> 5) & 7);
                attn_stage_kv(lds + 65536, z, ((uB >> 5) >> 3) * SEQ + (uB & 31) * 256, (uB >> 5) & 7);
            }
            const int u = 2 * pr + half;
            const int bh = u >> 5, ob = u & 31, b = bh >> 3, hd = bh & 7;
            LAS unsigned char* kvb = lds + half * 65536;
            bf16x8 qs[4];
            {
                const bf16_t* qp = z + (size_t)(b * SEQ + ob * 256 + wl * 32 + r31) * ZLD + hd * 64 + 8 * hh;
#pragma unroll
                for (int s2 = 0; s2 < 4; ++s2) qs[s2] = *(const bf16x8*)(qp + 16 * s2);
            }
            asm volatile("s_waitcnt vmcnt(0)" ::: "memory");
            __syncthreads();
            const int nvalid = ob < 3 ? ob : 3;
#pragma unroll 1
            for (int pass = 0; pass < 2; ++pass) {
                const int qt = pass ? 7 - wl : wl;
                const int sq = ob * 256 + qt * 32 + r31;
                const size_t pbase = ((size_t)bh * SEQ + sq) * 3;
                float mr[3], lr[3];
#pragma unroll
                for (int r = 0; r < 3; ++r) { mr[r] = -INFINITY; lr[r] = 0.f; if (r < nvalid) { const f32x2 ml = *(const f32x2*)(part_ml + (pbase + r) * 2); mr[r] = ml.x; lr[r] = ml.y; } }
                float mx, l; f32x16 o[2];
                attn_unit<false, HASDRY ? ATTN_STUB : 0>(kvb, qs, qt * 32 + r31, qt * 32, qt + 1, tbr, mx, l, o);
                mx += tabl[hd * 132 + 128];
                if (pass == 0) {
                    const bf16_t* qp2 = z + (size_t)(b * SEQ + ob * 256 + (7 - wl) * 32 + r31) * ZLD + hd * 64 + 8 * hh;
#pragma unroll
                    for (int s2 = 0; s2 < 4; ++s2) qs[s2] = *(const bf16x8*)(qp2 + 16 * s2);
                }
                float M = mx;
#pragma unroll
                for (int r = 0; r < 3; ++r) M = fmaxf(M, mr[r]);
                const float wo = fast_exp2(mx - M);
                float wr[3], den = l * wo;
#pragma unroll
                for (int r = 0; r < 3; ++r) { wr[r] = (r < nvalid) ? lr[r] * fast_exp2(mr[r] - M) : 0.f; den += wr[r]; }
                const float inv = 1.0f / den;
                const float a_o = wo * inv, a_0 = wr[0] * inv, a_1 = wr[1] * inv, a_2 = wr[2] * inv;
                LAS unsigned char* stg = lds + LDS_MISC + MISC_STG + wave * 2560;
                const size_t prow0 = ((size_t)bh * SEQ + ob * 256 + qt * 32) * 3;
                bf16_t* op0 = ab + (size_t)(b * SEQ + ob * 256 + qt * 32) * D + hd * 64;
#pragma unroll
                for (int c = 0; c < 2; ++c) {
#pragma unroll
                    for (int g = 0; g < 4; ++g)
                        *(LAS u32x2*)(stg + r31 * 80 + (8 * g + 4 * hh) * 2) = (u32x2){pk2(o[c][4 * g] * a_o, o[c][4 * g + 1] * a_o), pk2(o[c][4 * g + 2] * a_o, o[c][4 * g + 3] * a_o)};
                    asm volatile("s_waitcnt lgkmcnt(0)" ::: "memory");
#pragma unroll
                    for (int i = 0; i < 2; ++i) {
                        const int row = i * 16 + (lane >> 2), chunk = lane & 3;
                        const u32x4 own = *(LAS u32x4*)(stg + row * 80 + chunk * 16);
                        float f[8] = {bflo(own.x), bfhi(own.x), bflo(own.y), bfhi(own.y), bflo(own.z), bfhi(own.z), bflo(own.w), bfhi(own.w)};
#pragma unroll
                        for (int r = 0; r < 3; ++r)
                            if (r < nvalid) {
                                const float ar = __shfl(r == 0 ? a_0 : (r == 1 ? a_1 : a_2), row);
                                const u32x4 w = *(const u32x4*)(part_o + (prow0 + (size_t)row * 3 + r) * 64 + c * 32 + chunk * 8);
                                f[0] += ar * bflo(w.x); f[1] += ar * bfhi(w.x); f[2] += ar * bflo(w.y); f[3] += ar * bfhi(w.y);
                                f[4] += ar * bflo(w.z); f[5] += ar * bfhi(w.z); f[6] += ar * bflo(w.w); f[7] += ar * bfhi(w.w);
                            }
                        *(u32x4*)(op0 + (size_t)row * D + c * 32 + chunk * 8) = (u32x4){pk2(f[0], f[1]), pk2(f[2], f[3]), pk2(f[4], f[5]), pk2(f[6], f[7])};
                    }
                    asm volatile("s_waitcnt lgkmcnt(0)" ::: "memory");
                }
            }
        }
        __syncthreads();
    }
    }
    if constexpr (!HASDRY) xcd_barrier(bar);
    {
        unsigned char* wsl = (unsigned char*)karg_ptr(168);
        x = (const float*)karg_ptr(8 * 0);
        g_ffn = (const float*)karg_ptr(8 * 8);
        w_gate = (const float*)karg_ptr(8 * 13);
        w_up = (const float*)karg_ptr(8 * 14);
        w_down = (const float*)karg_ptr(8 * 15);
        out = (float*)karg_ptr(160);
        ss1 = (float*)(wsl + WS_SS1P);
        WoutT = (bf16_t*)(wsl + WS_WOUT);
        xb = (bf16_t*)(wsl + WS_XB);
        WguT = (bf16_t*)(wsl + WS_Z);
        WdT = (bf16_t*)(wsl + WS_PARTO);
        ab = (bf16_t*)(wsl + WS_AB);
    }

    if constexpr (PH(6)) {
    {
        {
            SchedDense S6{64, 4, G, (int)blockIdx.x, 1024, (const unsigned char*)WoutT};
            gemm8(lds, (const unsigned char*)ab, 1024, S6, EpiX1{xb, ss1, dry});
        }
        __syncthreads();
        LAS float* tl = (LAS float*)lds;
        {
            f32x4 vc[8], vn[8];
            int it = vcu;
            if (it < 2048) { const int kind = it >> 10, r = it & 1023, e = r >> 5, tt = r & 31;
                transpose_load(vc, (kind ? w_up : w_gate) + (size_t)e * 1024 * 512, 512, (tt >> 1) * 64, (tt & 1) * 256); }
            for (; it < 2048; it += G) {
                const int nx = it + G;
                if (nx < 2048) { const int kind = nx >> 10, r = nx & 1023, e = r >> 5, tt = r & 31;
                    transpose_load(vn, (kind ? w_up : w_gate) + (size_t)e * 1024 * 512, 512, (tt >> 1) * 64, (tt & 1) * 256); }
                { const int kind = it >> 10, r = it & 1023, e = r >> 5, tt = r & 31;
                  transpose_finish(vc, 1024, WguT + (size_t)e * 1024 * 1024, (tt >> 1) * 64, (tt & 1) * 256, g_ffn, kind ? 2 : 1, tl); }
#pragma unroll
                for (int i = 0; i < 8; ++i) vc[i] = vn[i];
            }
        }
    }
    }
    if constexpr (!HASDRY) xcd_barrier(bar);
    {
        unsigned char* wsl = (unsigned char*)karg_ptr(168);
        cnt_exp = (unsigned*)(wsl + OFF_CNT_EXP);
        ss1 = (float*)(wsl + WS_SS1P);
        routeb = (float*)(wsl + WS_RB);
        WrT = (bf16_t*)(wsl + WS_WR);
        xb = (bf16_t*)(wsl + WS_XB);
        tok_list = (unsigned*)(wsl + WS_TOK);
        gate_list = (float*)(wsl + WS_GW);
        rstd0 = (float*)(wsl + WS_RSTD0);
    }

    if constexpr (PH(7)) {
    {
        LAS float* lgp = (LAS float*)(lds + 98304);
        LAS unsigned char* wr_l = lds;
        LAS unsigned* hist = (LAS unsigned*)marr;
        __syncthreads();
#pragma unroll
        for (int i = 0; i < 12; ++i) {
            const int pc = wave * 12 + i, row = pc >> 1, dc = (pc & 1) * 64 + lane;
            __builtin_amdgcn_global_load_lds((const unsigned*)(WrT + (size_t)row * 1024 + (dc ^ (row & 7)) * 8), (LAS unsigned*)(wr_l + pc * 1024), 16, 0, 0);
        }
        asm volatile("s_waitcnt vmcnt(0)" ::: "memory");
        __syncthreads();
        for (int ug = vcu; ug < 256; ug += G) {
            __syncthreads();
            if (tid < 32) hist[tid] = 0u;
            const int grp = ug * 4 + (wave >> 1), khalf = wave & 1;
            const int m0 = grp * 16;
            f32x4 ac[3];
#pragma unroll
            for (int n = 0; n < 3; ++n) ac[n] = (f32x4){0.f, 0.f, 0.f, 0.f};
            const bf16_t* ap = xb + (size_t)(m0 + fr) * D + khalf * 512 + fq * 8;
            bf16x8 af[16];
#pragma unroll
            for (int ks = 0; ks < 16; ++ks) af[ks] = *(const bf16x8*)(ap + ks * 32);
#pragma unroll
            for (int ks = 0; ks < 16; ++ks) {
#pragma unroll
                for (int n = 0; n < 3; ++n) {
                    const int row = n * 16 + fr, ch = khalf * 64 + ks * 4 + fq;
                    const bf16x8 bf = *(LAS bf16x8*)(wr_l + row * 2048 + ((ch ^ (row & 7)) << 4));
                    ac[n] = mfma16(af[ks], bf, ac[n]);
                }
            }
#pragma unroll
            for (int n = 0; n < 3; ++n)
#pragma unroll
                for (int r = 0; r < 4; ++r) lgp[wave * 768 + (fq * 4 + r) * 48 + n * 16 + fr] = ac[n][r];
            __syncthreads();
            int e0 = 0, e1 = 0; float g0 = 0.f, g1 = 0.f; unsigned lp0 = 0, lp1 = 0; int token = 0;
            const bool act = (khalf == 0) && (lane < 16);
            if (act) {
                token = m0 + lane;
                float ssum = 0.f;
                { const f32x4* pp4 = (const f32x4*)(ss1 + (size_t)token * 16); const f32x4 p0 = pp4[0], p1 = pp4[1], p2 = pp4[2], p3 = pp4[3];
                  ssum = ((p0.x + p0.y) + (p0.z + p0.w)) + ((p1.x + p1.y) + (p1.z + p1.w)) + ((p2.x + p2.y) + (p2.z + p2.w)) + ((p3.x + p3.y) + (p3.z + p3.w)); }
                const float rs = rsqrtf(ssum * (1.0f / D) + EPS);
                if (!dry) rstd0[token] = rs;
                float lg[36];
#pragma unroll
                for (int c = 0; c < 36; ++c) lg[c] = (lgp[wave * 768 + lane * 48 + c] + lgp[(wave + 1) * 768 + lane * 48 + c]) * rs + routeb[c];
                int gs = 0; float gm = lg[0];
#pragma unroll
                for (int c = 1; c < 4; ++c) if (lg[c] > gm) { gm = lg[c]; gs = c; }
                float se = 0.f;
#pragma unroll
                for (int c = 0; c < 4; ++c) se += __expf(lg[c] - gm);
                const float pg = 1.0f / se;
                float l2[8];
#pragma unroll
                for (int c = 0; c < 8; ++c) l2[c] = gs == 0 ? lg[4 + c] : (gs == 1 ? lg[12 + c] : (gs == 2 ? lg[20 + c] : lg[28 + c]));
                int a0 = 0; float va = l2[0];
#pragma unroll
                for (int c = 1; c < 8; ++c) if (l2[c] > va) { va = l2[c]; a0 = c; }
                int a1 = -1; float vb = -INFINITY;
#pragma unroll
                for (int c = 0; c < 8; ++c) if (c != a0 && l2[c] > vb) { vb = l2[c]; a1 = c; }
                const float wa = 1.0f / (1.0f + __expf(vb - va));
                e0 = gs * 8 + a0; e1 = gs * 8 + a1; g0 = pg * wa; g1 = pg * (1.0f - wa);
                if (dry) { if (g0 + g1 == 12345.f) cnt_exp[0] = (unsigned)(e0 + e1); }
                else { lp0 = atomicAdd((unsigned*)&hist[e0], 1u);
                lp1 = atomicAdd((unsigned*)&hist[e1], 1u); }
            }
            __syncthreads();
            if (tid < 32) { const unsigned c = hist[tid]; hist[32 + tid] = c ? atomicAdd(&cnt_exp[tid], c) : 0u; }
            __syncthreads();
            if (act && !dry) {
                const unsigned p0 = hist[32 + e0] + lp0, p1 = hist[32 + e1] + lp1;
                tok_list[e0 * 16384 + p0] = (unsigned)token; gate_list[e0 * 16384 + p0] = g0;
                tok_list[e1 * 16384 + p1] = (unsigned)token | (1u << 14); gate_list[e1 * 16384 + p1] = g1;
            }
        }
    }
    }
    if constexpr (!HASDRY) xcd_barrier(bar);
    {
        unsigned char* wsl = (unsigned char*)karg_ptr(168);
        x = (const float*)karg_ptr(8 * 0);
        cnt_exp = (unsigned*)(wsl + OFF_CNT_EXP);
        ss1 = (float*)(wsl + WS_SS1P);
        xb = (bf16_t*)(wsl + WS_XB);
        WguT = (bf16_t*)(wsl + WS_Z);
        tok_list = (unsigned*)(wsl + WS_TOK);
        gate_list = (float*)(wsl + WS_GW);
        hid = (bf16_t*)(wsl + WS_AB);
        w_down = (const float*)karg_ptr(8 * 15);
        WdT = (bf16_t*)(wsl + WS_PARTO);
        pb = (bf16_t*)(wsl + WS_PB);
        ppb = (bf16_t*)(wsl + WS_PP);
        WpleT = (bf16_t*)(wsl + WS_WPLE);
        rstd0 = (float*)(wsl + WS_RSTD0);
    }

    LAS int* ecnt = marr;
    LAS int* epre = marr + 32;
    LAS int* ehoff = marr + 72;
    __syncthreads();
    if (wave == 0) {
        const int c = lane < 32 ? (int)cnt_exp[lane] : 0;
        int tp2 = ((c + 255) >> 8) * 4, ho = c;
#pragma unroll
        for (int o2 = 1; o2 < 64; o2 <<= 1) { const int a2 = __shfl_up(tp2, o2), b2 = __shfl_up(ho, o2); if (lane >= o2) { tp2 += a2; ho += b2; } }
        if (lane < 32) { ecnt[lane] = c; epre[lane + 1] = tp2; ehoff[lane + 1] = ho; }
        if (lane == 0) { epre[0] = 0; ehoff[0] = 0; }
    }
    __syncthreads();
    if constexpr (PH(8)) {
        SchedMoe S8{ecnt, epre, ehoff, G, (int)blockIdx.x, 1024, (const unsigned char*)WguT, (size_t)1024 * 1024 * 2, tok_list, 0};
        gemm8(lds, (const unsigned char*)xb, 1024, S8, EpiHid{hid, tok_list, gate_list, rstd0, ehoff});
        {
            const int nwg8 = epre[32], c8 = (int)blockIdx.x;
            const int nmax = (nwg8 + G - 1) / G, nheavy = nwg8 - (nmax - 1) * G;
            const int nlight = nheavy >= G ? G : G - nheavy, li = nheavy >= G ? c8 : c8 - nheavy;
            if (li >= 0) {
                f32x4 vc[8], vn[8];
                int it = li;
                if (it < 1024) { const int e = it >> 5, tt = it & 31; transpose_load(vc, w_down + (size_t)e * 512 * 1024, 1024, (tt >> 2) * 64, (tt & 3) * 256); }
                for (; it < 1024; it += nlight) {
                    const int nx = it + nlight;
                    if (nx < 1024) { const int e = nx >> 5, tt = nx & 31; transpose_load(vn, w_down + (size_t)e * 512 * 1024, 1024, (tt >> 2) * 64, (tt & 3) * 256); }
                    { const int e = it >> 5, tt = it & 31; transpose_finish(vc, 512, WdT + (size_t)e * 1024 * 512, (tt >> 2) * 64, (tt & 3) * 256, nullptr, 0, (LAS float*)lds); }
#pragma unroll
                    for (int i = 0; i < 8; ++i) vc[i] = vn[i];
                }
            }
        }
    }
    if constexpr (!HASDRY) xcd_barrier(bar);
    {
        unsigned char* wsl = (unsigned char*)karg_ptr(168);
        x = (const float*)karg_ptr(8 * 0);
        yslot = (bf16_t*)(wsl + WS_Z);
        tok_list = (unsigned*)(wsl + WS_TOK);
        WdT = (bf16_t*)(wsl + WS_PARTO);
        hid = (bf16_t*)(wsl + WS_AB);
        pb = (bf16_t*)(wsl + WS_PB);
        ppb = (bf16_t*)(wsl + WS_PP);
        WpleT = (bf16_t*)(wsl + WS_WPLE);
    }
    if constexpr (PH(9)) {
        SchedMoe S9{ecnt, epre, ehoff, G, (int)blockIdx.x, 512, (const unsigned char*)WdT, (size_t)1024 * 512 * 2, tok_list, 1};
        gemm8(lds, (const unsigned char*)hid, 512, S9, EpiY{yslot, tok_list});
        {
            const int nwg9 = epre[32], c9 = (int)blockIdx.x;
            const int nmax = (nwg9 + G - 1) / G, nheavy = nwg9 - (nmax - 1) * G;
            const int nlight = nheavy >= G ? G : G - nheavy, li = nheavy >= G ? c9 : c9 - nheavy;
            SchedLight S2{64, 4, 256, li, nlight, li >= 0, (const unsigned char*)WpleT};
            gemm8(lds, (const unsigned char*)pb, 256, S2, EpiBf16Plain{ppb, D});
        }
    }
    if constexpr (!HASDRY) xcd_barrier(bar);
    {
        unsigned char* wsl = (unsigned char*)karg_ptr(168);
        x = (const float*)karg_ptr(8 * 0);
        out = (float*)karg_ptr(160);
        rstd2 = (float*)(wsl + WS_RSTD2);
        xb = (bf16_t*)(wsl + WS_XB);
        z = (bf16_t*)(wsl + WS_Z);
        yslot = (bf16_t*)(wsl + WS_Z);
    }

    if constexpr (PH(10)) {
    for (int row = (vcu * 8 + wave) * 2; row < T; row += G * 16) {
        u32x2* xr = (u32x2*)(xb + (size_t)row * D) + lane;
        const u32x2* y0 = (const u32x2*)(yslot + (size_t)row * D) + lane;
        const u32x2* y1 = (const u32x2*)(yslot + ((size_t)T + row) * D) + lane;
        u32x2 xv[8], a[8], c[8];
#pragma unroll
        for (int j = 0; j < 8; ++j) { xv[j] = xr[64 * j]; a[j] = y0[64 * j]; c[j] = y1[64 * j]; }
        float s0 = 0.f, s1 = 0.f;
#pragma unroll
        for (int j = 0; j < 8; ++j) {
            const float vx = bflo(xv[j].x) + bflo(a[j].x) + bflo(c[j].x), vy = bfhi(xv[j].x) + bfhi(a[j].x) + bfhi(c[j].x);
            const float vz = bflo(xv[j].y) + bflo(a[j].y) + bflo(c[j].y), vw = bfhi(xv[j].y) + bfhi(a[j].y) + bfhi(c[j].y);
            if (!dry) xr[64 * j] = (u32x2){pk2(vx, vy), pk2(vz, vw)};
            const float q = (vx * vx + vy * vy) + (vz * vz + vw * vw);
            if (j < 4) s0 += q; else s1 += q;
        }
        s0 = wave_sum(s0); s1 = wave_sum(s1);
        if (lane == 0 && !dry) { rstd2[row] = rsqrtf(s0 * (1.0f / D) + EPS); rstd2[row + 1] = rsqrtf(s1 * (1.0f / D) + EPS); }
    }
    }
    if constexpr (!HASDRY) xcd_barrier(bar);
    {
        unsigned char* wsl = (unsigned char*)karg_ptr(168);
        x = (const float*)karg_ptr(8 * 0);
        out = (float*)karg_ptr(160);
        ss3 = (float*)(wsl + OFF_SS3);
        rstd2 = (float*)(wsl + WS_RSTD2);
        WpgT = (bf16_t*)(wsl + WS_WPG);
        xb = (bf16_t*)(wsl + WS_XB);
        ppb = (bf16_t*)(wsl + WS_PP);
        g_final = (const float*)karg_ptr(8 * 19);
    }

    if constexpr (PH(11)) {
    {
        SchedDense S11{64, 4, G, (int)blockIdx.x, 1024, (const unsigned char*)WpgT};
        if (G == 256) gemm8(lds, (const unsigned char*)xb, 1024, S11, EpiX3F{xb, out, ppb, rstd2, ss3, (unsigned*)(ws + OFF_PCNT), g_final});
        else gemm8(lds, (const unsigned char*)xb, 1024, S11, EpiX3{xb, out, ppb, rstd2, ss3, dry});
    }
    }
    if constexpr (!HASDRY) { if (G != 256) xcd_barrier(bar); }
    {
        unsigned char* wsl = (unsigned char*)karg_ptr(168);
        g_final = (const float*)karg_ptr(8 * 19);
        out = (float*)karg_ptr(160);
        ss3 = (float*)(wsl + OFF_SS3);
    }

    if constexpr (PH(12)) {
    if (G != 256)
    for (int row = vcu * 8 + wave; row < T; row += G * 8) {
        f32x4* xr = (f32x4*)(out + (size_t)row * D) + lane;
        const f32x4* gf = (const f32x4*)g_final + lane;
        const float rs = rsqrtf(ss3[row] * (1.0f / D) + EPS);
#pragma unroll
        for (int j = 0; j < 4; ++j) { f32x4 v = xr[64 * j]; const f32x4 g = gf[64 * j]; v = v * rs * g; if (!dry) xr[64 * j] = v; }
    }
    }
}

extern "C" void kernel_launch(void* const* d_in, const int* in_sizes, int n_in, void* d_out, int out_size, void* d_ws, size_t ws_size, hipStream_t stream) {
    static int grid = 0;
    if (grid == 0) {
        int dev = 0, cus = 0, per_cu = 0;
        if (n_in != 20 || out_size != T * D || ws_size < WS_END) { fprintf(stderr, "kernel_launch: unexpected shapes (n_in %d out %d ws %zu)\n", n_in, out_size, ws_size); grid = -1; return; }
        if (hipGetDevice(&dev) != hipSuccess || hipDeviceGetAttribute(&cus, hipDeviceAttributeMultiprocessorCount, dev) != hipSuccess) { grid = -1; return; }
        if (hipFuncSetAttribute((const void*)hymba_fwd<0x1FFFu, false>, hipFuncAttributeMaxDynamicSharedMemorySize, LDS_BYTES) != hipSuccess) { fprintf(stderr, "kernel_launch: hipFuncSetAttribute failed\n"); grid = -1; return; }
        if (hipOccupancyMaxActiveBlocksPerMultiprocessor(&per_cu, (const void*)hymba_fwd<0x1FFFu, false>, NT, LDS_BYTES) != hipSuccess || per_cu < 1) { fprintf(stderr, "kernel_launch: occupancy query says %d blocks per CU\n", per_cu); (void)hipGetLastError(); grid = -1; return; }
        grid = cus;
    }
    if (grid < 0) return;
    (void)hipMemsetAsync((char*)d_ws + WS_CTL, 0, CTL_BYTES, stream);
    Params p{};
    for (int i = 0; i < 20; ++i) p.in[i] = (const float*)d_in[i];
    p.out = (float*)d_out; p.ws = (unsigned char*)d_ws;
    hipLaunchKernelGGL((hymba_fwd<0x1FFFu, false>), dim3(grid), dim3(NT), LDS_BYTES, stream, p);
#if PROF_PHASES
    p.dry = 1;
#define PROF_ONE(k) do { if (PROF_PHASES & (1u << (k))) { (void)hipFuncSetAttribute((const void*)hymba_fwd<(1u << (k)), true>, hipFuncAttributeMaxDynamicSharedMemorySize, LDS_BYTES); \
        hipLaunchKernelGGL((hymba_fwd<(1u << (k)), true>), dim3(grid), dim3(NT), LDS_BYTES, stream, p); } } while (0)
    PROF_ONE(0); PROF_ONE(1); PROF_ONE(2); PROF_ONE(3); PROF_ONE(4); PROF_ONE(5); PROF_ONE(6); PROF_ONE(7); PROF_ONE(8); PROF_ONE(9); PROF_ONE(10); PROF_ONE(11); PROF_ONE(12);
#endif
}
```

```cpp
#include <hip/hip_runtime.h>
#include <stdint.h>
#include <stdio.h>

#define DI __device__ __forceinline__
#define LAS __attribute__((address_space(3)))

typedef unsigned short bf16_t;
typedef short bf16x8 __attribute__((ext_vector_type(8)));
typedef short s16x4 __attribute__((ext_vector_type(4)));
typedef float f32x2 __attribute__((ext_vector_type(2)));
typedef float f32x4 __attribute__((ext_vector_type(4)));
typedef float f32x16 __attribute__((ext_vector_type(16)));
typedef unsigned u32x2 __attribute__((ext_vector_type(2)));
typedef unsigned u32x4 __attribute__((ext_vector_type(4)));

constexpr int T = 16384, D = 1024, SEQ = 8192, NH = 8, NBLK = 32;
constexpr int ZLD = 2048;
constexpr float EPS = 1e-6f;
constexpr float LOG2E = 1.4426950408889634f;
constexpr int NT = 512;
#define PH(k) (((MASK) >> (k)) & 1)
#ifndef PROF_PHASES
#define PROF_PHASES 0
#endif

constexpr size_t MiB = 1u << 20;
constexpr size_t WS_CTL = 0, CTL_BYTES = 1 * MiB;
constexpr size_t OFF_CNT_SEL = 16384;
constexpr size_t OFF_CNT_EXP = 20480;
constexpr size_t OFF_PCNT = 24576;
constexpr size_t OFF_SS1 = 65536;
constexpr size_t OFF_SS3 = 131072;
constexpr size_t WS_KMEAN = 1 * MiB;
constexpr size_t WS_TAB = WS_KMEAN + 131072;
constexpr size_t WS_RSTD0 = WS_KMEAN + 196608;
constexpr size_t WS_RSTD2 = WS_KMEAN + 262144;
constexpr size_t WS_RB = WS_KMEAN + 327680;
constexpr size_t WS_SS1P = 2 * MiB;
constexpr size_t WS_WIN = 4 * MiB;
constexpr size_t WS_WOUT = 8 * MiB;
constexpr size_t WS_WPG = 10 * MiB;
constexpr size_t WS_WPLE = 12 * MiB;
constexpr size_t WS_WPOOL = 12 * MiB + 524288;
constexpr size_t WS_WR = 12 * MiB + 786432;
constexpr size_t WS_XB = 16 * MiB;
constexpr size_t WS_Z = 48 * MiB;
constexpr size_t WS_TOK = 112 * MiB;
constexpr size_t WS_GW = 114 * MiB;
constexpr size_t WS_SEL = 128 * MiB;
constexpr size_t WS_PARTO = 144 * MiB;
constexpr size_t WS_PARTML = 192 * MiB;
constexpr size_t WS_AB = 197 * MiB;
constexpr size_t WS_PB = 229 * MiB;
constexpr size_t WS_PP = 237 * MiB;
constexpr size_t WS_END = 269 * MiB;

constexpr int LDS_MISC = 131072;
constexpr int LDS_BYTES = 163840;
constexpr int MISC_ARR = 64;
constexpr int MISC_TAB = 4096;
constexpr int MISC_DESC = 8704;
constexpr int MISC_TBR = 10240;
constexpr int MISC_STG = 12288;

DI unsigned pk2(float lo, float hi) {
    typedef __bf16 b2 __attribute__((ext_vector_type(2)));
    f32x2 v = {lo, hi};
    b2 b = __builtin_convertvector(v, b2);
    return __builtin_bit_cast(unsigned, b);
}
DI float bflo(unsigned w) { return __uint_as_float(w << 16); }
DI float bfhi(unsigned w) { return __uint_as_float(w & 0xffff0000u); }
DI float wave_sum(float v) {
#pragma unroll
    for (int o = 1; o < 64; o <<= 1) v += __shfl_xor(v, o);
    return v;
}
DI f32x4 mfma16(bf16x8 a, bf16x8 b, f32x4 c) { return __builtin_amdgcn_mfma_f32_16x16x32_bf16(a, b, c, 0, 0, 0); }
DI f32x16 mfma32(bf16x8 a, bf16x8 b, f32x16 c) { return __builtin_amdgcn_mfma_f32_32x32x16_bf16(a, b, c, 0, 0, 0); }
DI float fast_exp2(float x) { return __builtin_amdgcn_exp2f(x); }
DI float fast_rcp(float x) { return __builtin_amdgcn_rcpf(x); }

#define XB_TMO      128
#define XB_XCNT(j)  (256  + 64 * (j))
#define XB_XSUB(j)  (1280 + 64 * (j))
#define XB_XGEN(j)  (2304 + 64 * (j))
#define XB_TOP      3328
#define XB_TOPGEN   3392
#define XCD_BAR_WORDS 3456
#define XB_SPIN_CAP (1u << 18)
DI unsigned xb_ld(unsigned* p)              { return __hip_atomic_load(p, __ATOMIC_RELAXED, __HIP_MEMORY_SCOPE_AGENT); }
DI unsigned xb_add(unsigned* p, unsigned v) { return __hip_atomic_fetch_add(p, v, __ATOMIC_RELAXED, __HIP_MEMORY_SCOPE_AGENT); }
DI unsigned xb_xcc_id() { return (unsigned)__builtin_amdgcn_s_getreg((3 << 11) | 20) & 0xFu; }
#define XB_SPIN(cond, bar) do { unsigned _sp = 0; while (cond) { __builtin_amdgcn_s_sleep(1); \
    if ((++_sp & 255u) == 0u) { if (xb_ld(&(bar)[XB_TMO])) break; if (_sp > XB_SPIN_CAP) { atomicAdd(&(bar)[XB_TMO], 1u); break; } } } } while (0)
struct XcdBarrier { unsigned* bar; unsigned x; volatile LAS unsigned* st; };
DI XcdBarrier xcd_barrier_post(unsigned* bar, volatile LAS unsigned* st) {
    XcdBarrier b; b.bar = bar; b.x = xb_xcc_id(); b.st = st;
    if (threadIdx.x == 0) (void)xb_add(&bar[XB_XCNT(b.x)], 1u);
    return b;
}
DI void xcd_barrier_complete(unsigned* bar, unsigned x, unsigned& nloc, unsigned& nx) {
    const unsigned G = gridDim.x * gridDim.y * gridDim.z;
    unsigned sum, cnt, mine, sp = 0u;
    for (;;) {
        sum = 0u; cnt = 0u; mine = 0u;
#pragma unroll
        for (unsigned j = 0; j < 16; ++j) { const unsigned c = xb_ld(&bar[XB_XCNT(j)]); sum += c; cnt += (c > 0u) ? 1u : 0u; mine = (j == x) ? c : mine; }
        if (sum == G) break;
        __builtin_amdgcn_s_sleep(1);
        if ((++sp & 255u) == 0u) { if (xb_ld(&bar[XB_TMO])) break; if (sp > XB_SPIN_CAP) { atomicAdd(&bar[XB_TMO], 1u); break; } }
    }
    nloc = mine > 0u ? mine : 1u; nx = cnt > 0u ? cnt : 1u;
}
struct NoHook { DI void operator()() const {} };
template <class Hook = NoHook>
DI void xcd_barrier(const XcdBarrier& b, Hook hook = Hook()) {
    asm volatile("s_waitcnt vmcnt(0)" ::: "memory");
    __syncthreads();
    if (threadIdx.x >= 64) hook();
    if (threadIdx.x == 0) {
        unsigned* bar = b.bar;
        __builtin_amdgcn_s_waitcnt(0);
        unsigned nloc = b.st[0], nx = b.st[1];
        if (nloc == 0u) { xcd_barrier_complete(bar, b.x, nloc, nx); b.st[0] = nloc; b.st[1] = nx; }
        const unsigned old = xb_add(&bar[XB_XSUB(b.x)], 1u);
        const unsigned gen = old / nloc;
        if (old + 1u == (gen + 1u) * nloc) {
            __builtin_amdgcn_fence(__ATOMIC_RELEASE, "agent");
            asm volatile("s_waitcnt vmcnt(0)" ::: "memory");
            const unsigned og = xb_add(&bar[XB_TOP], 1u);
            const unsigned tg = og / nx;
            if (og + 1u == (tg + 1u) * nx) xb_add(&bar[XB_TOPGEN], 1u);
            else XB_SPIN(xb_ld(&bar[XB_TOPGEN]) == tg, bar);
            __builtin_amdgcn_fence(__ATOMIC_ACQUIRE, "agent");
            xb_add(&bar[XB_XGEN(b.x)], 1u);
            asm volatile("s_waitcnt vmcnt(0)" ::: "memory");
        } else {
            XB_SPIN(xb_ld(&bar[XB_XGEN(b.x)]) == gen, bar);
            __builtin_amdgcn_fence(__ATOMIC_ACQUIRE, "agent");
            asm volatile("s_waitcnt vmcnt(0)" ::: "memory");
        }
    }
    __syncthreads();
}

constexpr int G8_HTB = 16384;
DI int g8_lds_byte(int r, int c) { const int st = (r >> 4) * 2 + (c >> 5), rr = r & 15, cc = c & 31, ob = rr * 64 + cc * 2; return st * 1024 + (ob ^ (((ob >> 9) & 1) << 5)); }
DI void g8_stage_rc(int b, int& R, int& C) { const int st = b / 1024, sb = b % 1024, swz = sb ^ (((sb >> 9) & 1) << 5); R = (st >> 1) * 16 + swz / 64; C = (st & 1) * 32 + (swz % 64) / 2; }
struct GUnit { int pm, pn, e, cnt; const unsigned char* bptr; };
typedef int i32x4 __attribute__((ext_vector_type(4)));
template <bool I8 = false, class Sched, class Epi>
DI void gemm8(LAS unsigned char* lds, const unsigned char* Abase, const int K, const Sched& S, const Epi& E) {
    const int tid = threadIdx.x, wid = __builtin_amdgcn_readfirstlane(tid >> 6), lane = tid & 63, wr = wid >> 2, wc = wid & 3, fr = lane & 15, fq = lane >> 4;
    const int nt = K / 64;
    int sR[2], sC[2]; unsigned voffB[2];
#pragma unroll
    for (int i = 0; i < 2; ++i) { g8_stage_rc(tid * 16 + i * 8192, sR[i], sC[i]);
        const int rho = sR[i] & 31, rb = (sR[i] & ~31) + 8 * ((rho & 15) >> 2) + 4 * (rho >> 4) + (rho & 3);
        voffB[i] = (unsigned)(rb * K + sC[i]) * 2u; }
    const unsigned kstep = 128u;
    const size_t hstep = (size_t)128 * K * 2;
    const unsigned ldsw = (unsigned)wid * 1024u;
    const int aoff = g8_lds_byte(wr * 64 + fr, fq * 8), boff = g8_lds_byte(wc * 32 + fr, fq * 8);
#define G8_SA(b, h) (((b) * 2 + (h)) * G8_HTB)
#define G8_SB(b, h) ((4 + (b) * 2 + (h)) * G8_HTB)
#define G8_STAGE_B(bufoff, gbase) do { _Pragma("unroll") for (int _i = 0; _i < 2; ++_i) \
        __builtin_amdgcn_global_load_lds((const unsigned*)((gbase) + voffB[_i]), (LAS unsigned*)(lds + (bufoff) + ldsw + _i * 8192), 16, 0, 0); } while (0)
#define G8_STAGE_A(bufoff, o0, o1, kb) do { \
        __builtin_amdgcn_global_load_lds((const unsigned*)(Abase + (o0) + (kb)), (LAS unsigned*)(lds + (bufoff) + ldsw), 16, 0, 0); \
        __builtin_amdgcn_global_load_lds((const unsigned*)(Abase + (o1) + (kb)), (LAS unsigned*)(lds + (bufoff) + ldsw + 8192), 16, 0, 0); } while (0)
#define G8_LDA(dst, b, h) do { _Pragma("unroll") for (int m = 0; m < 4; ++m) _Pragma("unroll") for (int k = 0; k < 2; ++k) dst[m][k] = *(const LAS bf16x8*)(lds + G8_SA(b, h) + aoff + m * 2048 + k * 1024); } while (0)
#define G8_LDB(dst, b, h) do { _Pragma("unroll") for (int n = 0; n < 2; ++n) _Pragma("unroll") for (int k = 0; k < 2; ++k) dst[n][k] = *(const LAS bf16x8*)(lds + G8_SB(b, h) + boff + n * 2048 + k * 1024); } while (0)
#define G8_MMA(ai, bj, At, Bt) do { __builtin_amdgcn_s_setprio(1); _Pragma("unroll") for (int m = 0; m < 4; ++m) _Pragma("unroll") for (int n = 0; n < 2; ++n) _Pragma("unroll") for (int k = 0; k < 2; ++k) \
        acc[ai][bj][m][n] = I8 ? __builtin_bit_cast(f32x4, __builtin_amdgcn_mfma_i32_16x16x64_i8(__builtin_bit_cast(i32x4, Bt[n][k]), __builtin_bit_cast(i32x4, At[m][k]), __builtin_bit_cast(i32x4, acc[ai][bj][m][n]), 0, 0, 0)) \
                                      : __builtin_amdgcn_mfma_f32_16x16x32_bf16(Bt[n][k], At[m][k], acc[ai][bj][m][n], 0, 0, 0); __builtin_amdgcn_s_setprio(0); } while (0)
#define G8_WAIT_V(n) asm volatile("s_waitcnt vmcnt(" #n ")" ::: "memory")
#define G8_WAIT_L(n) asm volatile("s_waitcnt lgkmcnt(" #n ")" ::: "memory")
#define G8_BAR __builtin_amdgcn_s_barrier()
#define G8_SCHED __builtin_amdgcn_sched_barrier(0)
    GUnit cur, nxt; int ui = 0;
    if (!S.next(0, cur)) return;
    f32x4 acc[2][2][4][2];
#pragma unroll
    for (int a = 0; a < 2; ++a)
#pragma unroll
        for (int b = 0; b < 2; ++b)
#pragma unroll
            for (int m = 0; m < 4; ++m)
#pragma unroll
                for (int n = 0; n < 2; ++n) acc[a][b][m][n] = (f32x4){0.f, 0.f, 0.f, 0.f};
    bf16x8 At[4][2], B0[2][2], B1[2][2];
    unsigned oc[2][2], on[2][2];
    S.aoffs(cur, sR, sC, oc);
    const unsigned char* cB = cur.bptr;
    G8_STAGE_B(G8_SB(0, 0), cB); G8_STAGE_B(G8_SB(0, 1), cB + hstep); G8_STAGE_A(G8_SA(0, 0), oc[0][0], oc[0][1], 0u); G8_STAGE_A(G8_SA(0, 1), oc[1][0], oc[1][1], 0u);
    if (wr == 1) G8_BAR;
    G8_WAIT_V(2); G8_BAR;
    G8_STAGE_B(G8_SB(1, 0), cB + kstep); G8_STAGE_A(G8_SA(1, 0), oc[0][0], oc[0][1], kstep); G8_STAGE_B(G8_SB(1, 1), cB + hstep + kstep);
    G8_WAIT_V(6); G8_BAR;
    for (;;) {
        const bool has_next = S.next(ui + 1, nxt);
        if (has_next) S.aoffs(nxt, sR, sC, on);
        else {
#pragma unroll
            for (int h = 0; h < 2; ++h)
#pragma unroll
                for (int i = 0; i < 2; ++i) on[h][i] = oc[h][i];
        }
        const unsigned char* nB = has_next ? nxt.bptr : cB;
#pragma unroll 1
        for (int t = 0; t < nt; t += 2) {
            const bool last = (t == nt - 2);
            const unsigned k1 = (unsigned)(t + 1) * kstep;
            const unsigned k2 = last ? 0u : (unsigned)(t + 2) * kstep, k3 = k2 + kstep;
            const unsigned a2_00 = last ? on[0][0] : oc[0][0], a2_01 = last ? on[0][1] : oc[0][1], a2_10 = last ? on[1][0] : oc[1][0], a2_11 = last ? on[1][1] : oc[1][1];
            const unsigned char* b2 = (last ? nB : cB) + k2; const unsigned char* b3 = b2 + kstep;
            G8_LDB(B0, 0, 0); G8_LDB(B1, 0, 1); G8_SCHED; G8_LDA(At, 0, 0); G8_STAGE_A(G8_SA(1, 1), oc[1][0], oc[1][1], k1);
            G8_WAIT_V(8); G8_WAIT_L(0); G8_BAR; G8_MMA(0, 0, At, B0); G8_MMA(0, 1, At, B1); G8_BAR; G8_SCHED;
            G8_LDA(At, 0, 1); G8_STAGE_B(G8_SB(0, 0), b2); G8_STAGE_B(G8_SB(0, 1), b2 + hstep); G8_STAGE_A(G8_SA(0, 0), a2_00, a2_01, k2);
            G8_WAIT_V(8); G8_WAIT_L(0); G8_BAR; G8_MMA(1, 0, At, B0); G8_MMA(1, 1, At, B1); G8_BAR; G8_SCHED;
            G8_LDB(B0, 1, 0); G8_LDB(B1, 1, 1); G8_SCHED; G8_LDA(At, 1, 0); G8_STAGE_A(G8_SA(0, 1), a2_10, a2_11, k2);
            G8_WAIT_V(8); G8_WAIT_L(0); G8_BAR; G8_MMA(0, 0, At, B0); G8_MMA(0, 1, At, B1); G8_BAR; G8_SCHED;
            G8_LDA(At, 1, 1); G8_STAGE_B(G8_SB(1, 0), b3); G8_STAGE_B(G8_SB(1, 1), b3 + hstep); G8_STAGE_A(G8_SA(1, 0), a2_00, a2_01, k3);
            G8_WAIT_V(8); G8_WAIT_L(0); G8_BAR; G8_MMA(1, 0, At, B0); G8_MMA(1, 1, At, B1); G8_BAR; G8_SCHED;
        }
        if (wr == 0) G8_BAR;
        E(acc, cur, wr, wc, fr, fq);
        if (!has_next) break;
#pragma unroll
        for (int a = 0; a < 2; ++a)
#pragma unroll
            for (int b = 0; b < 2; ++b)
#pragma unroll
                for (int m = 0; m < 4; ++m)
#pragma unroll
                    for (int n = 0; n < 2; ++n) acc[a][b][m][n] = (f32x4){0.f, 0.f, 0.f, 0.f};
        cur = nxt; cB = nB; ++ui;
#pragma unroll
        for (int h = 0; h < 2; ++h)
#pragma unroll
            for (int i = 0; i < 2; ++i) oc[h][i] = on[h][i];
        if (wr == 1) G8_BAR;
    }
    G8_WAIT_V(0);
    G8_BAR;
#undef G8_SA
#undef G8_SB
#undef G8_STAGE_A
#undef G8_STAGE_B
#undef G8_LDA
#undef G8_LDB
#undef G8_MMA
#undef G8_WAIT_V
#undef G8_WAIT_L
#undef G8_BAR
#undef G8_SCHED
}
template <int W>
DI void pool_build(LAS unsigned char* lds, const bf16_t* z, int mt, int g) {
    const int tid = threadIdx.x, ch16 = tid & 15, r0 = (tid >> 4) * 8;
    const int t0 = mt * 256 + r0, s0 = t0 & (SEQ - 1);
    const bf16_t* up = z + (size_t)t0 * ZLD + 1536 + g * 128 + ch16 * 8;
    u32x4 rows[W + 7];
#pragma unroll
    for (int j = 0; j < W + 7; ++j) {
        const int d = j - (W - 1);
        rows[j] = (s0 + d >= 0) ? *(const u32x4*)(up + (ptrdiff_t)d * ZLD) : (u32x4){0u, 0u, 0u, 0u};
    }
    float a8[8];
#pragma unroll
    for (int q = 0; q < 8; ++q) a8[q] = 0.f;
#pragma unroll
    for (int j = 0; j < W - 1; ++j) { const u32x4 v = rows[j];
        a8[0] += bflo(v.x); a8[1] += bfhi(v.x); a8[2] += bflo(v.y); a8[3] += bfhi(v.y); a8[4] += bflo(v.z); a8[5] += bfhi(v.z); a8[6] += bflo(v.w); a8[7] += bfhi(v.w); }
#pragma unroll
    for (int i = 0; i < 8; ++i) {
        const u32x4 cur = rows[W - 1 + i];
        a8[0] += bflo(cur.x); a8[1] += bfhi(cur.x); a8[2] += bflo(cur.y); a8[3] += bfhi(cur.y); a8[4] += bflo(cur.z); a8[5] += bfhi(cur.z); a8[6] += bflo(cur.w); a8[7] += bfhi(cur.w);
        const int s = s0 + i, row = r0 + i;
        const float rc = 1.0f / (float)((s + 1 < W) ? (s + 1) : W);
        const u32x4 o = {pk2(a8[0] * rc - bflo(cur.x), a8[1] * rc - bfhi(cur.x)), pk2(a8[2] * rc - bflo(cur.y), a8[3] * rc - bfhi(cur.y)),
                         pk2(a8[4] * rc - bflo(cur.z), a8[5] * rc - bfhi(cur.z)), pk2(a8[6] * rc - bflo(cur.w), a8[7] * rc - bfhi(cur.w))};
        *(LAS u32x4*)(lds + (ch16 >> 3) * 49152 + row * 128 + (((ch16 & 7) ^ (row & 7)) << 4)) = o;
        const u32x4 old = rows[i];
        a8[0] -= bflo(old.x); a8[1] -= bfhi(old.x); a8[2] -= bflo(old.y); a8[3] -= bfhi(old.y); a8[4] -= bflo(old.z); a8[5] -= bfhi(old.z); a8[6] -= bflo(old.w); a8[7] -= bfhi(old.w);
    }
}
DI void pool_unit(f32x4 (&acc)[4][4], LAS unsigned char* lds, const bf16_t* z, int mt, int g, const unsigned char* Bb, const unsigned (&boff)[2]) {
    const int tid = threadIdx.x, lane = tid & 63;
    const int wave = __builtin_amdgcn_readfirstlane(tid >> 6), wm = wave >> 1, wn = wave & 1;
    const int fr = lane & 15, fq = lane >> 4;
    const unsigned xk0 = (unsigned)((fq ^ (lane & 7)) << 4), xk1 = (unsigned)(((4 + fq) ^ (lane & 7)) << 4);
    const unsigned ard = (unsigned)(wm * 64 + fr) * 128u, brd = 32768u + (unsigned)(wn * 64 + fr) * 128u;
    const unsigned wbase = (unsigned)wave * 1024u;
    __syncthreads();
#pragma unroll
    for (int st = 0; st < 2; ++st)
#pragma unroll
        for (int i = 0; i < 2; ++i)
            __builtin_amdgcn_global_load_lds((const unsigned*)(Bb + boff[i] + (unsigned)st * 128u), (LAS unsigned*)(lds + st * 49152 + 32768 + wbase + i * 8192), 16, 0, 0);
    if (g == 0) pool_build<2>(lds, z, mt, g); else if (g == 1) pool_build<4>(lds, z, mt, g); else if (g == 2) pool_build<8>(lds, z, mt, g); else pool_build<16>(lds, z, mt, g);
    asm volatile("s_waitcnt vmcnt(0)" ::: "memory");
    __syncthreads();
#pragma unroll
    for (int st = 0; st < 2; ++st) {
        LAS unsigned char* sb = lds + st * 49152;
#pragma unroll
        for (int ks = 0; ks < 2; ++ks) {
            const unsigned xk = ks ? xk1 : xk0;
            bf16x8 af[4], bfr[4];
#pragma unroll
            for (int m = 0; m < 4; ++m) af[m] = *(LAS bf16x8*)(sb + ard + m * 2048 + xk);
#pragma unroll
            for (int n = 0; n < 4; ++n) bfr[n] = *(LAS bf16x8*)(sb + brd + n * 2048 + xk);
#pragma unroll
            for (int m = 0; m < 4; ++m)
#pragma unroll
                for (int n = 0; n < 4; ++n) acc[m][n] = mfma16(bfr[n], af[m], acc[m][n]);
        }
    }
    __syncthreads();
}
DI void zero_acc(f32x4 (&acc)[4][4]) {
#pragma unroll
    for (int m = 0; m < 4; ++m)
#pragma unroll
        for (int n = 0; n < 4; ++n) acc[m][n] = (f32x4){0.f, 0.f, 0.f, 0.f};
}

DI void transpose_load(f32x4 (&v)[8], const float* src, int ldn, int k0, int n0) {
    const int tid = threadIdx.x, lk = tid >> 6, ln4 = (tid & 63) * 4;
#pragma unroll
    for (int i = 0; i < 8; ++i) v[i] = *(const f32x4*)(src + (size_t)(k0 + lk + 8 * i) * ldn + n0 + ln4);
}
DI void transpose_finish(const f32x4 (&v)[8], int K, bf16_t* dst, int k0, int n0, const float* gk, int mode, LAS float* t) {
    const int tid = threadIdx.x;
    const int lk = tid >> 6, ln4 = (tid & 63) * 4;
#pragma unroll
    for (int i = 0; i < 8; ++i) { LAS float* p = t + (lk + 8 * i) * 257 + ln4; p[0] = v[i].x; p[1] = v[i].y; p[2] = v[i].z; p[3] = v[i].w; }
    __syncthreads();
    const int c = tid & 7, nn = tid >> 3;
    float g[8];
#pragma unroll
    for (int j = 0; j < 8; ++j) g[j] = gk ? gk[k0 + c * 8 + j] : 1.0f;
#pragma unroll
    for (int i = 0; i < 4; ++i) {
        const int n = nn + 64 * i;
        float e[8];
#pragma unroll
        for (int j = 0; j < 8; ++j) e[j] = t[(c * 8 + j) * 257 + n] * g[j];
        const int f = n0 + n;
        const int drow = (mode == 0) ? f : ((f >> 7) * 256 + (mode == 2 ? 128 : 0) + (f & 127));
        const u32x4 o = {pk2(e[0], e[1]), pk2(e[2], e[3]), pk2(e[4], e[5]), pk2(e[6], e[7])};
        *(u32x4*)(dst + (size_t)drow * K + k0 + c * 8) = o;
    }
    __syncthreads();
}
DI void transpose_tile(const float* src, int ldn, int K, bf16_t* dst, int k0, int n0, const float* gk, int mode, LAS float* t) {
    f32x4 v[8];
    transpose_load(v, src, ldn, k0, n0);
    transpose_finish(v, K, dst, k0, n0, gk, mode, t);
}

DI void glds16_asm(const void* gsrc, unsigned lds_dst) {
    unsigned keep;
    asm volatile("s_mov_b32 %0, m0\n\ts_mov_b32 m0, %2\n\ts_nop 0\n\tglobal_load_lds_dwordx4 %1, off\n\ts_mov_b32 m0, %0" : "=&s"(keep) : "v"(gsrc), "s"(lds_dst) : "memory");
}
DI void attn_stage_kv_part(LAS unsigned char* buf, const bf16_t* z, int tok0, int hd, int wave) {
    const int tid = threadIdx.x, lane = tid & 63;
    const int kchunk = (lane & 7) ^ ((((wave & 1) << 2) + (lane >> 4)) & 7);
    const int vchunk = (lane & 7) ^ (((lane >> 4) & 1) << 2);
    const unsigned b0 = (unsigned)__builtin_amdgcn_readfirstlane((int)(unsigned)(size_t)buf) + (unsigned)wave * 1024u;
#pragma unroll
    for (int i = 0; i < 4; ++i) {
        const bf16_t* rowp = z + (size_t)(tok0 + wave * 8 + (lane >> 3) + 64 * i) * ZLD + hd * 64;
        glds16_asm(rowp + 512 + kchunk * 8, b0 + 8192u * i);
        glds16_asm(rowp + 1024 + vchunk * 8, b0 + 32768u + 8192u * i);
    }
}
DI void attn_stage_kv(LAS unsigned char* buf, const bf16_t* z, int tok0, int hd) { attn_stage_kv_part(buf, z, tok0, hd, __builtin_amdgcn_readfirstlane((int)(threadIdx.x >> 6))); }
DI int crow(int i, int h) { return (i & 3) + 8 * (i >> 2) + 4 * h; }

#ifndef ATTN_STUB
#define ATTN_STUB 0
#endif
#define SBAR() __builtin_amdgcn_sched_barrier(0)
#define PIN(x) asm volatile("" : "+v"(x))
#define MX3(a, b, c) __builtin_fmaxf(__builtin_fmaxf((a), (b)), (c))
constexpr float ATT_THR = 8.0f;
DI int wave_min_i32(int v) {
#define DPPMIN(ctrl, rmask) { const int t_ = __builtin_amdgcn_update_dpp(v, v, ctrl, rmask, 0xf, false); v = t_ < v ? t_ : v; }
    DPPMIN(0x111, 0xf) DPPMIN(0x112, 0xf) DPPMIN(0x114, 0xf) DPPMIN(0x118, 0xf) DPPMIN(0x142, 0xa) DPPMIN(0x143, 0xc)
#undef DPPMIN
    return __builtin_amdgcn_readlane(v, 63);
}
DI float xhalf_max(float v) { const auto rr = __builtin_amdgcn_permlane32_swap(__float_as_uint(v), __float_as_uint(v), false, false); return __builtin_fmaxf(__uint_as_float(rr[0]), __uint_as_float(rr[1])); }
DI float xhalf_sum(float v) { const auto rr = __builtin_amdgcn_permlane32_swap(__float_as_uint(v), __float_as_uint(v), false, false); return __uint_as_float(rr[0]) + __uint_as_float(rr[1]); }
template <bool FULL, int STUB>
DI void attn_unit(LAS unsigned char* lds, const bf16x8 (&qf)[4], int dbase, int dlo, int n, const LAS float* tbr, float& m_out, float& l_out, f32x16 (&o)[2]) {
    const int lane = threadIdx.x & 63, r31 = lane & 31, hh = lane >> 5;
    const int tq = (lane & 15) >> 2, tp = lane & 3, tblk = (lane >> 4) & 1;
    if (STUB == 2) { m_out = 0.f; l_out = 1.f;
#pragma unroll
        for (int i = 0; i < 16; ++i) { o[0][i] = qf[0][0]; o[1][i] = qf[1][0]; }
        return; }
    const unsigned kxor = (unsigned)((r31 >> 1) & 7);
    const unsigned vxr = (unsigned)(((tq >> 1) & 1) << 6);
    LAS unsigned char* const vp0 = lds + 32768u + (unsigned)(4 * hh + tq) * 128u + (vxr + 32u * tblk + 8u * tp);
    LAS unsigned char* const vp1 = lds + 32768u + (unsigned)(4 * hh + tq) * 128u + ((64u ^ vxr) + 32u * tblk + 8u * tp);
    LAS unsigned char* kp[4];
#pragma unroll
    for (int s2 = 0; s2 < 4; ++s2) kp[s2] = lds + r31 * 128 + ((((unsigned)(2 * s2 + hh)) ^ kxor) << 4);
    bf16x8 kf[4], vf[4]; u32x4 pw0, pw1; f32x16 sA, sB, cinit;
    float mref = 0.f, ls0 = 0.f, ls1 = 0.f, rm, a_, b_;
#pragma unroll
    for (int i = 0; i < 16; ++i) { o[0][i] = 0.f; o[1][i] = 0.f; }
#define TCL(t) (FULL ? (t) : ((t) < 7 ? (t) : 7))
#define KLD(s2, t) kf[s2] = *(LAS bf16x8*)(kp[s2] + (t) * 4096)
#define VLD(j, t) do { LAS unsigned char* p_ = (((j) & 1) ? vp1 : vp0) + (t) * 4096 + ((j) >> 1) * 2048; \
        const s16x4 a0_ = __builtin_amdgcn_ds_read_tr16_b64_v4i16((LAS s16x4*)p_), a1_ = __builtin_amdgcn_ds_read_tr16_b64_v4i16((LAS s16x4*)(p_ + 1024)); \
        vf[j] = __builtin_shufflevector(a0_, a1_, 0, 1, 2, 3, 4, 5, 6, 7); } while (0)
#define BIAS(S, t) do { if (dlo - ((t) * 32 + 31) < 128) { int d0_ = dbase - 4 * hh - (t) * 32; d0_ = d0_ > 255 ? 255 : d0_; const LAS float* bp_ = tbr + (255 - d0_); \
        _Pragma("unroll") for (int i = 0; i < 16; ++i) S[i] += bp_[crow(i, 0)]; } } while (0)
#define ROWMAX_TAIL() do { rm = xhalf_max(__builtin_fmaxf(a_, b_)); } while (0)
#define MOVE_REF(S, dl_, FIRST) do { const float dl = (dl_); mref += dl; \
        if (!(FIRST)) { const float f_ = fast_exp2(-dl); ls0 *= f_; ls1 *= f_; _Pragma("unroll") for (int i = 0; i < 16; ++i) { o[0][i] *= f_; o[1][i] *= f_; } } \
        _Pragma("unroll") for (int i = 0; i < 16; ++i) { S[i] -= dl; cinit[i] = -mref; } } while (0)
#define PART1(S) do { SBAR(); \
        o[0] = mfma32(vf[0], __builtin_bit_cast(bf16x8, pw0), o[0]); a_ = MX3(S[0], S[1], S[2]); b_ = MX3(S[3], S[4], S[5]); PIN(a_); PIN(b_); SBAR(); \
        o[1] = mfma32(vf[1], __builtin_bit_cast(bf16x8, pw0), o[1]); a_ = MX3(a_, S[6], S[7]); b_ = MX3(b_, S[8], S[9]); PIN(a_); PIN(b_); SBAR(); \
        o[0] = mfma32(vf[2], __builtin_bit_cast(bf16x8, pw1), o[0]); a_ = MX3(a_, S[10], S[11]); b_ = MX3(b_, S[12], S[13]); PIN(a_); PIN(b_); SBAR(); \
        o[1] = mfma32(vf[3], __builtin_bit_cast(bf16x8, pw1), o[1]); a_ = MX3(a_, S[14], S[15]); ROWMAX_TAIL(); PIN(rm); SBAR(); } while (0)
#define GAP2(S, SN, t, s2, PW, w0, CIN) do { \
        if (!FULL || (t) < 7) SN = mfma32(kf[s2], qf[s2], CIN); \
        VLD(s2, t); \
        S[4 * (s2)] = fast_exp2(S[4 * (s2)]); S[4 * (s2) + 1] = fast_exp2(S[4 * (s2) + 1]); S[4 * (s2) + 2] = fast_exp2(S[4 * (s2) + 2]); S[4 * (s2) + 3] = fast_exp2(S[4 * (s2) + 3]); \
        ls0 += S[4 * (s2)]; ls1 += S[4 * (s2) + 1]; ls0 += S[4 * (s2) + 2]; ls1 += S[4 * (s2) + 3]; \
        PW[w0] = pk2(S[4 * (s2)], S[4 * (s2) + 1]); PW[(w0) + 1] = pk2(S[4 * (s2) + 2], S[4 * (s2) + 3]); \
        if (!FULL || (t) < 6) KLD(s2, TCL((t) + 2)); \
        PIN(PW); PIN(ls0); PIN(ls1); SBAR(); } while (0)
#define PART2(S, SN, t) do { GAP2(S, SN, t, 0, pw0, 0, cinit); GAP2(S, SN, t, 1, pw0, 2, SN); GAP2(S, SN, t, 2, pw1, 0, SN); GAP2(S, SN, t, 3, pw1, 2, SN); } while (0)
#define STEP(S, SN, t) do { BIAS(S, t); PART1(S); \
        if (__builtin_expect(__any(rm > ATT_THR), 0)) MOVE_REF(S, __builtin_fmaxf(rm, 0.f), false); \
        PART2(S, SN, t); } while (0)
#pragma unroll
    for (int s2 = 0; s2 < 4; ++s2) KLD(s2, 0);
    sA = mfma32(kf[0], qf[0], (f32x16){0.f, 0.f, 0.f, 0.f, 0.f, 0.f, 0.f, 0.f, 0.f, 0.f, 0.f, 0.f, 0.f, 0.f, 0.f, 0.f});
    sA = mfma32(kf[1], qf[1], sA); sA = mfma32(kf[2], qf[2], sA); sA = mfma32(kf[3], qf[3], sA);
    SBAR();
#pragma unroll
    for (int s2 = 0; s2 < 4; ++s2) KLD(s2, 1);
    BIAS(sA, 0);
    a_ = MX3(sA[0], sA[1], sA[2]); b_ = MX3(sA[3], sA[4], sA[5]); a_ = MX3(a_, sA[6], sA[7]); b_ = MX3(b_, sA[8], sA[9]);
    a_ = MX3(a_, sA[10], sA[11]); b_ = MX3(b_, sA[12], sA[13]); a_ = MX3(a_, sA[14], sA[15]); ROWMAX_TAIL();
    MOVE_REF(sA, rm, true);
    SBAR();
    PART2(sA, sB, 0);
    if (FULL) { STEP(sB, sA, 1); STEP(sA, sB, 2); STEP(sB, sA, 3); STEP(sA, sB, 4); STEP(sB, sA, 5); STEP(sA, sB, 6); STEP(sB, sA, 7); }
    else {
        int t = 1;
#pragma unroll 1
        for (; t + 1 < n; t += 2) { STEP(sB, sA, t); STEP(sA, sB, t + 1); }
        if (t < n) STEP(sB, sA, t);
    }
    SBAR();
    o[0] = mfma32(vf[0], __builtin_bit_cast(bf16x8, pw0), o[0]); o[1] = mfma32(vf[1], __builtin_bit_cast(bf16x8, pw0), o[1]);
    o[0] = mfma32(vf[2], __builtin_bit_cast(bf16x8, pw1), o[0]); o[1] = mfma32(vf[3], __builtin_bit_cast(bf16x8, pw1), o[1]);
    m_out = mref; l_out = xhalf_sum(ls0 + ls1);
#undef TCL
#undef KLD
#undef VLD
#undef BIAS
#undef ROWMAX_TAIL
#undef MOVE_REF
#undef PART1
#undef GAP2
#undef PART2
#undef STEP
}

DI int xcd_remap(int L, int nwg) { const int q = nwg / 8, r = nwg % 8, xcd = L % 8, off = L / 8; return (xcd < r ? xcd * (q + 1) : r * (q + 1) + (xcd - r) * q) + off; }
struct SchedDense {
    int nM, nN, G, c, K; const unsigned char* Bt;
    DI bool next(int i, GUnit& u) const {
        const int nwg = nM * nN; const int L = i * G + c; if (L >= nwg) return false;
        const int wgid = xcd_remap(L, nwg);
        const int nig = 8 * nN, gid = wgid / nig, fm = gid * 8, gsz = (nM - fm) < 8 ? (nM - fm) : 8;
        u.pm = fm + ((wgid % nig) % gsz); u.pn = (wgid % nig) / gsz; u.e = 0; u.cnt = 0;
        u.bptr = Bt + (size_t)u.pn * 256 * K * 2; return true;
    }
    DI void aoffs(const GUnit& u, const int (&R)[2], const int (&C)[2], unsigned (&o)[2][2]) const {
#pragma unroll
        for (int h = 0; h < 2; ++h)
#pragma unroll
            for (int i = 0; i < 2; ++i) o[h][i] = (unsigned)((u.pm * 256 + 128 * h + R[i]) * K + C[i]) * 2u;
    }
};
struct SchedLight {
    int nM, nN, K, first, stride; bool active; const unsigned char* Bt;
    DI bool next(int i, GUnit& u) const {
        const int L = first + i * stride; if (!active || L >= nM * nN) return false;
        u.pm = L / nN; u.pn = L % nN; u.e = 0; u.cnt = 0; u.bptr = Bt + (size_t)u.pn * 256 * K * 2; return true;
    }
    DI void aoffs(const GUnit& u, const int (&R)[2], const int (&C)[2], unsigned (&o)[2][2]) const {
#pragma unroll
        for (int h = 0; h < 2; ++h)
#pragma unroll
            for (int i = 0; i < 2; ++i) o[h][i] = (unsigned)((u.pm * 256 + 128 * h + R[i]) * K + C[i]) * 2u;
    }
};
struct SchedMoe {
    const LAS int* ecnt; const LAS int* epre; const LAS int* ehoff; int G, c, K; const unsigned char* Bt; size_t bstride;
    const unsigned* tok_list; int mode;
    DI bool next(int i, GUnit& u) const {
        const int nwg = epre[32]; const int L = i * G + c; if (L >= nwg) return false;
        const int wgid = xcd_remap(L, nwg);
        int e = 0;
        while (epre[e + 1] <= wgid) ++e;
        const int loc = wgid - epre[e];
        u.e = e; u.cnt = ecnt[e]; u.pm = loc >> 2; u.pn = loc & 3;
        u.bptr = Bt + (size_t)e * bstride + (size_t)u.pn * 256 * K * 2; return true;
    }
    DI void aoffs(const GUnit& u, const int (&R)[2], const int (&C)[2], unsigned (&o)[2][2]) const {
#pragma unroll
        for (int h = 0; h < 2; ++h)
#pragma unroll
            for (int i = 0; i < 2; ++i) {
                int r = u.pm * 256 + 128 * h + R[i]; r = r < u.cnt ? r : u.cnt - 1;
                const unsigned row = mode == 0 ? (tok_list[u.e * 16384 + r] & 0x3FFFu) : (unsigned)(ehoff[u.e] + r);
                o[h][i] = (row * (unsigned)K + (unsigned)C[i]) * 2u;
            }
    }
};
#define EPI_LOOP_BEGIN \
    _Pragma("unroll") for (int ai = 0; ai < 2; ++ai) _Pragma("unroll") for (int m = 0; m < 4; ++m) { const int rl = 128 * ai + 64 * wr + 16 * m + fr;
#define EPI_LOOP_END }
struct EpiZ {
    bf16_t* z; const float* rstd0; float* kmean; LAS float* red;
    DI void operator()(const f32x4 (&acc)[2][2][4][2], const GUnit& u, int wr, int wc, int fr, int fq) const {
        f32x4 cs[2][2];
        const float qsc = u.pn < 2 ? 0.125f * LOG2E : 1.0f;
#pragma unroll
        for (int bj = 0; bj < 2; ++bj)
#pragma unroll
            for (int n = 0; n < 2; ++n) cs[bj][n] = (f32x4){0.f, 0.f, 0.f, 0.f};
        EPI_LOOP_BEGIN
            const int row = u.pm * 256 + rl; const float rs = rstd0[row] * qsc;
#pragma unroll
            for (int bj = 0; bj < 2; ++bj)
#pragma unroll
                for (int n = 0; n < 2; ++n) { const int col = u.pn * 256 + 128 * bj + 32 * wc + 8 * fq + 4 * n; const f32x4 v = acc[ai][bj][m][n] * rs;
                    cs[bj][n] += v;
                    *(u32x2*)(z + (size_t)row * ZLD + col) = (u32x2){pk2(v.x, v.y), pk2(v.z, v.w)}; }
        EPI_LOOP_END
        if (u.pn == 2 || u.pn == 3) {
#pragma unroll
            for (int bj = 0; bj < 2; ++bj)
#pragma unroll
                for (int n = 0; n < 2; ++n)
#pragma unroll
                    for (int q = 0; q < 4; ++q) { float v = cs[bj][n][q]; v += __shfl_xor(v, 1); v += __shfl_xor(v, 2); v += __shfl_xor(v, 4); v += __shfl_xor(v, 8);
                        if (fr == 0) red[wr * 256 + 128 * bj + 32 * wc + 8 * fq + 4 * n + q] = v; }
            asm volatile("s_waitcnt lgkmcnt(0)" ::: "memory"); __builtin_amdgcn_s_barrier(); asm volatile("" ::: "memory");
            const int t = threadIdx.x;
            if (t < 256) { const float sm = red[t] + red[256 + t]; const int col = u.pn * 256 + t - 512;
                kmean[(((u.pm >> 5) * 8 + (col >> 6)) * 32 + (u.pm & 31)) * 64 + (col & 63)] = sm * (1.0f / 256.0f); }
            asm volatile("s_waitcnt lgkmcnt(0)" ::: "memory"); __builtin_amdgcn_s_barrier(); asm volatile("" ::: "memory");
        }
    }
};
struct EpiBf16Plain {
    bf16_t* o; int ld;
    DI void operator()(const f32x4 (&acc)[2][2][4][2], const GUnit& u, int wr, int wc, int fr, int fq) const {
        EPI_LOOP_BEGIN
            const int row = u.pm * 256 + rl;
#pragma unroll
            for (int bj = 0; bj < 2; ++bj)
#pragma unroll
                for (int n = 0; n < 2; ++n) { const int col = u.pn * 256 + 128 * bj + 32 * wc + 8 * fq + 4 * n; const f32x4 v = acc[ai][bj][m][n];
                    *(u32x2*)(o + (size_t)row * ld + col) = (u32x2){pk2(v.x, v.y), pk2(v.z, v.w)}; }
        EPI_LOOP_END
    }
};
struct EpiX1 {
    bf16_t* xb; float* ss; bool dry;
    DI void operator()(const f32x4 (&acc)[2][2][4][2], const GUnit& u, int wr, int wc, int fr, int fq) const {
        EPI_LOOP_BEGIN
            const int row = u.pm * 256 + rl; float sq = 0.f;
#pragma unroll
            for (int bj = 0; bj < 2; ++bj) { const int col = u.pn * 256 + 128 * bj + 32 * wc + 8 * fq;
                u32x4* px = (u32x4*)(xb + (size_t)row * D + col);
                const u32x4 xw = *px;
                const f32x4 v0 = (f32x4){bflo(xw.x), bfhi(xw.x), bflo(xw.y), bfhi(xw.y)} + acc[ai][bj][m][0];
                const f32x4 v1 = (f32x4){bflo(xw.z), bfhi(xw.z), bflo(xw.w), bfhi(xw.w)} + acc[ai][bj][m][1];
                if (!dry) *px = (u32x4){pk2(v0.x, v0.y), pk2(v0.z, v0.w), pk2(v1.x, v1.y), pk2(v1.z, v1.w)};
                sq += ((v0.x * v0.x + v0.y * v0.y) + (v0.z * v0.z + v0.w * v0.w)) + ((v1.x * v1.x + v1.y * v1.y) + (v1.z * v1.z + v1.w * v1.w)); }
            sq += __shfl_xor(sq, 16); sq += __shfl_xor(sq, 32);
            if (fq == 0 && !dry) ss[row * 16 + u.pn * 4 + wc] = sq;
        EPI_LOOP_END
    }
};
struct EpiHid {
    bf16_t* hid; const f32x2* gate_list; const LAS int* ehoff;
    DI void operator()(const f32x4 (&acc)[2][2][4][2], const GUnit& u, int wr, int wc, int fr, int fq) const {
        EPI_LOOP_BEGIN
            const int r = u.pm * 256 + rl;
            if (r < u.cnt) {
                const f32x2 gr = gate_list[u.e * 16384 + r];
                const float gw = gr.x, rs = gr.y;
                bf16_t* hp = hid + (size_t)(ehoff[u.e] + r) * 512 + u.pn * 128 + 32 * wc + 8 * fq;
                float h8[8];
#pragma unroll
                for (int n = 0; n < 2; ++n) {
                    const f32x4 a = acc[ai][0][m][n] * rs, uu = acc[ai][1][m][n] * rs;
#pragma unroll
                    for (int q = 0; q < 4; ++q) { const float sg = a[q] * fast_rcp(1.0f + __expf(-a[q])); h8[4 * n + q] = sg * uu[q] * gw; }
                }
                *(u32x4*)hp = (u32x4){pk2(h8[0], h8[1]), pk2(h8[2], h8[3]), pk2(h8[4], h8[5]), pk2(h8[6], h8[7])};
            }
        EPI_LOOP_END
    }
};
struct EpiY {
    bf16_t* yslot; const unsigned* tok_list;
    DI void operator()(const f32x4 (&acc)[2][2][4][2], const GUnit& u, int wr, int wc, int fr, int fq) const {
        EPI_LOOP_BEGIN
            const int r = u.pm * 256 + rl;
            if (r < u.cnt) {
                const unsigned ent = tok_list[u.e * 16384 + r]; const unsigned tok = ent & 0x3FFFu, slot = ent >> 14;
                bf16_t* yp = yslot + ((size_t)slot * T + tok) * D;
#pragma unroll
                for (int bj = 0; bj < 2; ++bj)
#pragma unroll
                    for (int n = 0; n < 2; ++n) { const int col = u.pn * 256 + 128 * bj + 32 * wc + 8 * fq + 4 * n; const f32x4 v = acc[ai][bj][m][n];
                        *(u32x2*)(yp + col) = (u32x2){pk2(v.x, v.y), pk2(v.z, v.w)}; }
            }
        EPI_LOOP_END
    }
};
struct EpiX3F {
    const bf16_t* x2; float* out; const bf16_t* pp; const float* rstd2; float* ss; unsigned* pcnt; const float* gfin;
    DI void operator()(f32x4 (&acc)[2][2][4][2], const GUnit& u, int wr, int wc, int fr, int fq) const {
        EPI_LOOP_BEGIN
            const int row = u.pm * 256 + rl; const float rs = rstd2[row]; float sq = 0.f;
#pragma unroll
            for (int bj = 0; bj < 2; ++bj) { const int col = u.pn * 256 + 128 * bj + 32 * wc + 8 * fq;
                const u32x4 xw = *(const u32x4*)(x2 + (size_t)row * D + col);
                const u32x4 pw = *(const u32x4*)(pp + (size_t)row * D + col);
                const float xv[8] = {bflo(xw.x), bfhi(xw.x), bflo(xw.y), bfhi(xw.y), bflo(xw.z), bfhi(xw.z), bflo(xw.w), bfhi(xw.w)};
                const float pv[8] = {bflo(pw.x), bfhi(pw.x), bflo(pw.y), bfhi(pw.y), bflo(pw.z), bfhi(pw.z), bflo(pw.w), bfhi(pw.w)};
#pragma unroll
                for (int n = 0; n < 2; ++n) { f32x4 v;
#pragma unroll
                    for (int q = 0; q < 4; ++q) { const float gt = fast_rcp(1.0f + __expf(-acc[ai][bj][m][n][q] * rs)); v[q] = xv[4 * n + q] + pv[4 * n + q] * gt; }
                    acc[ai][bj][m][n] = v;
                    sq += (v.x * v.x + v.y * v.y) + (v.z * v.z + v.w * v.w); } }
            sq += __shfl_xor(sq, 16); sq += __shfl_xor(sq, 32);
            if (fq == 0) atomicAdd(&ss[row], sq);
        EPI_LOOP_END
        asm volatile("s_waitcnt vmcnt(0)" ::: "memory");
        unsigned* pc = pcnt + 64 * u.pm;
        if ((threadIdx.x & 63) == 0) __hip_atomic_fetch_add(pc, 1u, __ATOMIC_RELAXED, __HIP_MEMORY_SCOPE_AGENT);
        for (unsigned spins = 0; spins < (1u << 22); ++spins) {
            const unsigned c = (unsigned)__builtin_amdgcn_readfirstlane((int)__hip_atomic_load(pc, __ATOMIC_RELAXED, __HIP_MEMORY_SCOPE_AGENT));
            if (c >= 32u) break;
            __builtin_amdgcn_s_sleep(2);
        }
        EPI_LOOP_BEGIN
            const int row = u.pm * 256 + rl;
            const float r3 = rsqrtf(__hip_atomic_load(&ss[row], __ATOMIC_RELAXED, __HIP_MEMORY_SCOPE_AGENT) * (1.0f / D) + EPS);
#pragma unroll
            for (int bj = 0; bj < 2; ++bj)
#pragma unroll
                for (int n = 0; n < 2; ++n) { const int col = u.pn * 256 + 128 * bj + 32 * wc + 8 * fq + 4 * n;
                    const f32x4 g4 = *(const f32x4*)(gfin + col);
                    *(f32x4*)(out + (size_t)row * D + col) = acc[ai][bj][m][n] * r3 * g4; }
        EPI_LOOP_END
    }
};
struct EpiX3 {
    const bf16_t* x2; float* out; const bf16_t* pp; const float* rstd2; float* ss; bool dry;
    DI void operator()(const f32x4 (&acc)[2][2][4][2], const GUnit& u, int wr, int wc, int fr, int fq) const {
        EPI_LOOP_BEGIN
            const int row = u.pm * 256 + rl; const float rs = rstd2[row]; float sq = 0.f;
#pragma unroll
            for (int bj = 0; bj < 2; ++bj)
#pragma unroll
                for (int n = 0; n < 2; ++n) { const int col = u.pn * 256 + 128 * bj + 32 * wc + 8 * fq + 4 * n;
                    const u32x2 xw = *(const u32x2*)(x2 + (size_t)row * D + col);
                    f32x4 v = {bflo(xw.x), bfhi(xw.x), bflo(xw.y), bfhi(xw.y)};
                    const u32x2 pw = *(const u32x2*)(pp + (size_t)row * D + col);
                    const float p4[4] = {bflo(pw.x), bfhi(pw.x), bflo(pw.y), bfhi(pw.y)};
#pragma unroll
                    for (int q = 0; q < 4; ++q) { const float gt = fast_rcp(1.0f + __expf(-acc[ai][bj][m][n][q] * rs)); v[q] += p4[q] * gt; }
                    if (!dry) *(f32x4*)(out + (size_t)row * D + col) = v;
                    sq += (v.x * v.x + v.y * v.y) + (v.z * v.z + v.w * v.w); }
            sq += __shfl_xor(sq, 16); sq += __shfl_xor(sq, 32);
            if (fq == 0 && !dry) atomicAdd(&ss[row], sq);
        EPI_LOOP_END
    }
};

DI const void* karg_ptr(int byte_off) {
    unsigned long long p;
    asm volatile("s_load_dwordx2 %0, %1, %2\n\ts_waitcnt lgkmcnt(0)" : "=s"(p) : "s"(__builtin_amdgcn_kernarg_segment_ptr()), "i"(byte_off) : "memory");
    return (const void*)(const __attribute__((address_space(1))) void*)p;
}
struct Params {
    const float* in[20];
    float* out;
    unsigned char* ws;
    int dry, pad;
};

template <unsigned MASK, bool HASDRY>
__global__ void __launch_bounds__(NT, 2) hymba_fwd(Params P) {
    extern __shared__ __attribute__((aligned(16))) unsigned char smem_raw[];
    LAS unsigned char* lds = (LAS unsigned char*)smem_raw;
    const int tid = threadIdx.x, lane = tid & 63;
    const int wave = __builtin_amdgcn_readfirstlane(tid >> 6);
    const int G = gridDim.x;
    const int vcu = (G % 8 == 0) ? ((int)(blockIdx.x % 8) * (G / 8) + (int)(blockIdx.x / 8)) : (int)blockIdx.x;
    unsigned char* ws = (unsigned char*)karg_ptr(168);

    volatile LAS unsigned* misc = (volatile LAS unsigned*)(lds + LDS_MISC);
    if (tid < 4) misc[tid] = 0u;
    __syncthreads();
    const bool dry = HASDRY ? (P.dry != 0) : false; (void)dry;
    XcdBarrier bar; bar.bar = (unsigned*)(ws + WS_CTL); bar.x = 0; bar.st = misc;
    if (!HASDRY) bar = xcd_barrier_post((unsigned*)(ws + WS_CTL), misc);
    LAS int* marr = (LAS int*)(lds + LDS_MISC + MISC_ARR);

    const float* x;
    const float* pin;
    const float* g_mix;
    const float* w_in;
    const float* w_pool;
    const float* pool_scale;
    const float* w_out;
    const float* rel_bias;
    const float* g_ffn;
    const float* w_r1;
    const float* b_r1;
    const float* w_r2;
    const float* b_r2;
    const float* w_gate;
    const float* w_up;
    const float* w_down;
    const float* g_ple;
    const float* w_ple;
    const float* w_pg;
    const float* g_final;
    float* out;
    unsigned* cnt_sel;
    unsigned* cnt_exp;
    float* ss1;
    float* ss3;
    float* kmean;
    float* tab;
    float* rstd0;
    float* rstd2;
    float* routeb;
    bf16_t* WinT;
    bf16_t* WoutT;
    bf16_t* WpgT;
    bf16_t* WpleT;
    bf16_t* WpoolT;
    bf16_t* WrT;
    bf16_t* xb;
    bf16_t* z;
    bf16_t* WguT;
    bf16_t* yslot;
    unsigned* tok_list;
    f32x2* gate_list;
    unsigned* sel_list;
    bf16_t* part_o;
    bf16_t* WdT;
    float* part_ml;
    bf16_t* ab;
    bf16_t* hid;
    bf16_t* pb;
    bf16_t* ppb;
    {
        unsigned char* wsl = (unsigned char*)karg_ptr(168);
        x = (const float*)karg_ptr(8 * 0);
        pin = (const float*)karg_ptr(8 * 1);
        g_mix = (const float*)karg_ptr(8 * 2);
        w_in = (const float*)karg_ptr(8 * 3);
        w_pool = (const float*)karg_ptr(8 * 4);
        pool_scale = (const float*)karg_ptr(8 * 5);
        w_out = (const float*)karg_ptr(8 * 6);
        rel_bias = (const float*)karg_ptr(8 * 7);
        w_r1 = (const float*)karg_ptr(8 * 9);
        b_r1 = (const float*)karg_ptr(8 * 10);
        w_r2 = (const float*)karg_ptr(8 * 11);
        b_r2 = (const float*)karg_ptr(8 * 12);
        g_ple = (const float*)karg_ptr(8 * 16);
        w_ple = (const float*)karg_ptr(8 * 17);
        w_pg = (const float*)karg_ptr(8 * 18);
        tab = (float*)(wsl + WS_TAB);
        rstd0 = (float*)(wsl + WS_RSTD0);
        routeb = (float*)(wsl + WS_RB);
        WinT = (bf16_t*)(wsl + WS_WIN);
        WoutT = (bf16_t*)(wsl + WS_WOUT);
        WpgT = (bf16_t*)(wsl + WS_WPG);
        WpleT = (bf16_t*)(wsl + WS_WPLE);
        WpoolT = (bf16_t*)(wsl + WS_WPOOL);
        WrT = (bf16_t*)(wsl + WS_WR);
        xb = (bf16_t*)(wsl + WS_XB);
        z = (bf16_t*)(wsl + WS_Z);
        pb = (bf16_t*)(wsl + WS_PB);
        g_ffn = (const float*)karg_ptr(8 * 8);
    }

    const int srow = tid >> 3, sc = (tid & 7) ^ (srow & 7);
    const int wm = wave >> 1, wn = wave & 1, fr = lane & 15, fq = lane >> 4;
    const int r31 = lane & 31, hh = lane >> 5;

    if constexpr (PH(0)) {
    {
        for (int i = vcu * NT + tid; i < 65536 + 49152 + 1056 + 48; i += G * NT) {
            if (i < 65536) {
                const int g = i >> 14, n = (i >> 7) & 127, k = i & 127;
                WpoolT[i] = (bf16_t)(pk2(w_pool[(g * 128 + k) * 128 + n] * pool_scale[g * 128 + n], 0.f) & 0xffffu);
            } else if (i < 65536 + 49152) {
                const int j = i - 65536, n = j >> 10, k = j & 1023;
                float v = 0.f;
                if (n < 4) v = w_r1[k * 4 + n] * g_ffn[k];
                else if (n < 36) { const int gg = (n - 4) >> 3, e = (n - 4) & 7; v = w_r2[(gg * 1024 + k) * 8 + e] * g_ffn[k]; }
                WrT[j] = (bf16_t)(pk2(v, 0.f) & 0xffffu);
            } else if (i < 65536 + 49152 + 1056) {
                const int j = i - 65536 - 49152, h = j / 132, d = j % 132;
                int bk;
                if (d < 16) bk = d;
                else { bk = 16 + (int)(logf((float)d / 16.0f) / logf(8.0f) * 16.0f); bk = bk > 31 ? 31 : bk; }
                tab[j] = rel_bias[bk * 8 + h] * LOG2E;
            } else {
                const int j = i - 65536 - 49152 - 1056;
                routeb[j] = j < 4 ? b_r1[j] : (j < 36 ? b_r2[j - 4] : 0.f);
            }
        }
        LAS float* tl = (LAS float*)lds;
        for (int it = vcu; it < 272; it += G) {
            int r = it;
            if (r < 128) { transpose_tile(w_in, 2048, 1024, WinT, (r >> 3) * 64, (r & 7) * 256, g_mix, 0, tl); continue; } r -= 128;
            if (r < 64)  { transpose_tile(w_out, 1024, 1024, WoutT, (r >> 2) * 64, (r & 3) * 256, nullptr, 0, tl); continue; } r -= 64;
            if (r < 64)  { transpose_tile(w_pg, 1024, 1024, WpgT, (r >> 2) * 64, (r & 3) * 256, g_ple, 0, tl); continue; } r -= 64;
            transpose_tile(w_ple, 1024, 256, WpleT, (r >> 2) * 64, (r & 3) * 256, nullptr, 0, tl);
        }
        for (int i = vcu * NT + tid; i < T * 256 / 8; i += G * NT) {
            const f32x4 v0 = ((const f32x4*)pin)[2 * i], v1 = ((const f32x4*)pin)[2 * i + 1];
            ((u32x4*)pb)[i] = (u32x4){pk2(v0.x, v0.y), pk2(v0.z, v0.w), pk2(v1.x, v1.y), pk2(v1.z, v1.w)};
        }
        for (int row = (vcu * 8 + wave) * 2; row < T; row += G * 16) {
            const f32x4* xr = (const f32x4*)(x + (size_t)row * D) + lane;
            f32x4 v[8]; float s0 = 0.f, s1 = 0.f;
#pragma unroll
            for (int j = 0; j < 8; ++j) v[j] = xr[64 * j];
#pragma unroll
            for (int j = 0; j < 4; ++j) { s0 += (v[j].x * v[j].x + v[j].y * v[j].y) + (v[j].z * v[j].z + v[j].w * v[j].w);
                                          s1 += (v[4 + j].x * v[4 + j].x + v[4 + j].y * v[4 + j].y) + (v[4 + j].z * v[4 + j].z + v[4 + j].w * v[4 + j].w); }
            s0 = wave_sum(s0); s1 = wave_sum(s1);
            u32x2* o = (u32x2*)(xb + (size_t)row * D) + lane;
#pragma unroll
            for (int j = 0; j < 8; ++j) o[64 * j] = (u32x2){pk2(v[j].x, v[j].y), pk2(v[j].z, v[j].w)};
            if (lane == 0) { rstd0[row] = rsqrtf(s0 * (1.0f / D) + EPS); rstd0[row + 1] = rsqrtf(s1 * (1.0f / D) + EPS); }
        }
    }
    }
    if constexpr (!HASDRY) xcd_barrier(bar);
    {
        unsigned char* wsl = (unsigned char*)karg_ptr(168);
        x = (const float*)karg_ptr(8 * 0);
        rstd0 = (float*)(wsl + WS_RSTD0);
        WinT = (bf16_t*)(wsl + WS_WIN);
        xb = (bf16_t*)(wsl + WS_XB);
        z = (bf16_t*)(wsl + WS_Z);
        kmean = (float*)(wsl + WS_KMEAN);
    }

    if constexpr (PH(1)) {
    {
        SchedDense S1{64, 8, G, (int)blockIdx.x, 1024, (const unsigned char*)WinT};
        gemm8(lds, (const unsigned char*)xb, 1024, S1, EpiZ{z, rstd0, kmean, (LAS float*)(lds + LDS_MISC + 10240)});
    }
    }
    if constexpr (!HASDRY) xcd_barrier(bar);
    {
        unsigned char* wsl = (unsigned char*)karg_ptr(168);
        x = (const float*)karg_ptr(8 * 0);
        kmean = (float*)(wsl + WS_KMEAN);
        WpleT = (bf16_t*)(wsl + WS_WPLE);
        z = (bf16_t*)(wsl + WS_Z);
        pb = (bf16_t*)(wsl + WS_PB);
        ppb = (bf16_t*)(wsl + WS_PP);
    }

    {
        unsigned char* wsl = (unsigned char*)karg_ptr(168);
        x = (const float*)karg_ptr(8 * 0);
        cnt_sel = (unsigned*)(wsl + OFF_CNT_SEL);
        kmean = (float*)(wsl + WS_KMEAN);
        WpoolT = (bf16_t*)(wsl + WS_WPOOL);
        z = (bf16_t*)(wsl + WS_Z);
        sel_list = (unsigned*)(wsl + WS_SEL);
        ab = (bf16_t*)(wsl + WS_AB);
    }

    if constexpr (PH(3)) {
    {
        LAS unsigned char* kmh = lds;
        LAS unsigned char* kml = lds + 4096;
        LAS unsigned* hist = (LAS unsigned*)marr;
        for (int u = vcu; u < 256; u += G) {
            const int bh = u >> 4, ck = u & 15, b = bh >> 3, hd = bh & 7;
            const int s = ck * 512 + tid, ob = s >> 8;
            __syncthreads();
            {
                const int j = tid >> 4, d0 = (tid & 15) * 4;
                const f32x4 kv = *(const f32x4*)(kmean + (size_t)bh * 2048 + tid * 4);
                const unsigned h0 = pk2(kv.x, kv.y), h1 = pk2(kv.z, kv.w);
                const unsigned l0 = pk2(kv.x - bflo(h0), kv.y - bfhi(h0)), l1 = pk2(kv.z - bflo(h1), kv.w - bfhi(h1));
                const unsigned off = (unsigned)j * 128u + ((((unsigned)(d0 >> 3)) ^ (((unsigned)j >> 1) & 7u)) << 4) + (unsigned)(d0 & 7) * 2u;
                *(LAS u32x2*)(kmh + off) = (u32x2){h0, h1};
                *(LAS u32x2*)(kml + off) = (u32x2){l0, l1};
            }
            if (tid < 32) hist[tid] = 0u;
            bf16x8 qg[2][4];
#pragma unroll
            for (int t2 = 0; t2 < 2; ++t2) {
                const bf16_t* qp = z + (size_t)(b * SEQ + ck * 512 + wave * 64 + t2 * 32 + r31) * ZLD + hd * 64 + 8 * hh;
#pragma unroll
                for (int s2 = 0; s2 < 4; ++s2) qg[t2][s2] = *(const bf16x8*)(qp + 16 * s2);
            }
            __syncthreads();
            float v0 = -INFINITY, v1 = -INFINITY, v2 = -INFINITY; int i0 = 0, i1 = 0, i2 = 0;
#pragma unroll
            for (int t2 = 0; t2 < 2; ++t2) {
                f32x16 g16;
#pragma unroll
                for (int i = 0; i < 16; ++i) g16[i] = 0.f;
#pragma unroll
                for (int s2 = 0; s2 < 4; ++s2) {
                    const unsigned ko = (unsigned)r31 * 128u + ((((unsigned)(2 * s2 + hh)) ^ (((unsigned)r31 >> 1) & 7u)) << 4);
                    g16 = mfma32(*(LAS bf16x8*)(kmh + ko), qg[t2][s2], g16);
                    g16 = mfma32(*(LAS bf16x8*)(kml + ko), qg[t2][s2], g16);
                }
                float a0 = -INFINITY, a1 = -INFINITY, a2 = -INFINITY; int j0 = 64, j1 = 64, j2 = 64;
#pragma unroll
                for (int i = 0; i < 16; ++i) {
                    const int j = crow(i, hh); const float gv = (j < ob) ? g16[i] : -INFINITY;
                    if (gv > a2) {
                        if (gv > a1) { a2 = a1; j2 = j1; if (gv > a0) { a1 = a0; j1 = j0; a0 = gv; j0 = j; } else { a1 = gv; j1 = j; } }
                        else { a2 = gv; j2 = j; }
                    }
                }
                float pv[3] = {__shfl_xor(a0, 32), __shfl_xor(a1, 32), __shfl_xor(a2, 32)};
                int pj[3] = {__shfl_xor(j0, 32), __shfl_xor(j1, 32), __shfl_xor(j2, 32)};
#pragma unroll
                for (int k = 0; k < 3; ++k) {
                    const float gv = pv[k]; const int j = pj[k];
                    const bool b2 = gv > a2 || (gv == a2 && j < j2), b1 = gv > a1 || (gv == a1 && j < j1), b0 = gv > a0 || (gv == a0 && j < j0);
                    if (b2) {
                        if (b1) { a2 = a1; j2 = j1; if (b0) { a1 = a0; j1 = j0; a0 = gv; j0 = j; } else { a1 = gv; j1 = j; } }
                        else { a2 = gv; j2 = j; }
                    }
                }
                if (hh == t2) { v0 = a0; v1 = a1; v2 = a2; i0 = j0; i1 = j1; i2 = j2; }
            }
            i0 &= 31; i1 &= 31; i2 &= 31;
            const int nvalid = ob < 3 ? ob : 3;
            unsigned lp0 = 0, lp1 = 0, lp2 = 0;
            if (dry) { if (v0 + v1 + v2 == 12345.f) cnt_sel[0] = (unsigned)(i0 + i1 + i2); continue; }
            if (nvalid > 0) lp0 = atomicAdd((unsigned*)&hist[i0], 1u);
            if (nvalid > 1) lp1 = atomicAdd((unsigned*)&hist[i1], 1u);
            if (nvalid > 2) lp2 = atomicAdd((unsigned*)&hist[i2], 1u);
            __syncthreads();
            if (tid < 32) { const unsigned c = hist[tid]; hist[32 + tid] = c ? atomicAdd(&cnt_sel[bh * 32 + tid], c) : 0u; }
            __syncthreads();
            if (nvalid > 0) sel_list[(size_t)(bh * 32 + i0) * 8192 + hist[32 + i0] + lp0] = (unsigned)s | (0u << 13);
            if (nvalid > 1) sel_list[(size_t)(bh * 32 + i1) * 8192 + hist[32 + i1] + lp1] = (unsigned)s | (1u << 13);
            if (nvalid > 2) sel_list[(size_t)(bh * 32 + i2) * 8192 + hist[32 + i2] + lp2] = (unsigned)s | (2u << 13);
        }
        __syncthreads();
        for (int u = vcu; u < 256; u += G) {
            const int mt = u >> 2, g = u & 3;
            unsigned aoff[4], boff[2];
#pragma unroll
            for (int i = 0; i < 2; ++i) boff[i] = (unsigned)(((g * 128) + srow + 64 * i) * 128 + sc * 8) * 2u;
            f32x4 acc[4][4]; zero_acc(acc);
            pool_unit(acc, lds, z, mt, g, (const unsigned char*)WpoolT, boff);
#pragma unroll
            for (int m = 0; m < 4; ++m) {
                const int row = mt * 256 + wm * 64 + m * 16 + fr;
#pragma unroll
                for (int n = 0; n < 4; ++n) {
                    const int col = 512 + g * 128 + wn * 64 + n * 16 + fq * 4;
                    const f32x4 v = acc[m][n];
                    *(u32x2*)(ab + (size_t)row * D + col) = (u32x2){pk2(v.x, v.y), pk2(v.z, v.w)};
                }
            }
        }
    }
    }
    if constexpr (!HASDRY) xcd_barrier(bar);
    {
        unsigned char* wsl = (unsigned char*)karg_ptr(168);
        cnt_sel = (unsigned*)(wsl + OFF_CNT_SEL);
        tab = (float*)(wsl + WS_TAB);
        z = (bf16_t*)(wsl + WS_Z);
        sel_list = (unsigned*)(wsl + WS_SEL);
        part_o = (bf16_t*)(wsl + WS_PARTO);
        part_ml = (float*)(wsl + WS_PARTML);
    }

    if constexpr (PH(4)) {
    {
        LAS int* pre = marr;
        LAS float* tabl = (LAS float*)(lds + LDS_MISC + MISC_TAB);
        LAS int* desc = (LAS int*)(lds + LDS_MISC + MISC_DESC);
        __syncthreads();
        if (wave == 0) {
            const u32x4 c0 = *(const u32x4*)(cnt_sel + lane * 8), c1 = *(const u32x4*)(cnt_sel + lane * 8 + 4);
            int v[8] = {(int)((c0.x + 255u) >> 8), (int)((c0.y + 255u) >> 8), (int)((c0.z + 255u) >> 8), (int)((c0.w + 255u) >> 8),
                        (int)((c1.x + 255u) >> 8), (int)((c1.y + 255u) >> 8), (int)((c1.z + 255u) >> 8), (int)((c1.w + 255u) >> 8)};
#pragma unroll
            for (int i = 1; i < 8; ++i) v[i] += v[i - 1];
            int tot = v[7];
#pragma unroll
            for (int o2 = 1; o2 < 64; o2 <<= 1) { const int t2 = __shfl_up(tot, o2); if (lane >= o2) tot += t2; }
            const int base = tot - v[7];
            if (lane == 0) pre[0] = 0;
#pragma unroll
            for (int i = 0; i < 8; ++i) pre[lane * 8 + i + 1] = base + v[i];
        }
        __syncthreads();
        const int total = pre[512];
        for (int i = tid; i < 8 * 132; i += NT) { const int h = i / 132; tabl[i] = tab[i] - tab[h * 132 + 128]; }
        LAS float* c31l = (LAS float*)(lds + LDS_MISC + MISC_DESC + 1024);
        LAS float* tbr = (LAS float*)(lds + LDS_MISC + MISC_TBR);
        if (tid < 8) c31l[tid] = tab[tid * 132 + 128];
        const int nun = vcu < total ? (total - vcu + G - 1) / G : 0;
        if (tid < nun && tid < 64) {
            const int u = vcu + tid * G;
            int lo = 0, hi2 = 512;
            while (hi2 - lo > 1) { const int mid = (lo + hi2) >> 1; if (pre[mid] <= u) lo = mid; else hi2 = mid; }
            desc[tid * 4 + 0] = lo; desc[tid * 4 + 1] = u - pre[lo]; desc[tid * 4 + 2] = (int)cnt_sel[lo];
        }
        __syncthreads();
        if (nun > 0) {
            unsigned ent_c, ent_n = 0; bf16x8 qf[4], qn[4];
            {
                const int li = desc[0], cidx = desc[1], n = desc[2];
                const int bh = li >> 5, j = li & 31;
                if (tid < 256) { const int dist = 255 - tid; tbr[tid] = dist >= 128 ? 0.f : tabl[(bh & 7) * 132 + dist]; }
                attn_stage_kv(lds, z, (bh >> 3) * SEQ + j * 256, bh & 7);
                const int qb = cidx * 256 + wave * 32, qi = qb + r31;
                ent_c = sel_list[(size_t)li * 8192 + ((qi < n) ? qi : cidx * 256)];
                const bf16_t* qp = z + (size_t)((bh >> 3) * SEQ + (int)(ent_c & 8191u)) * ZLD + (bh & 7) * 64 + 8 * hh;
#pragma unroll
                for (int s2 = 0; s2 < 4; ++s2) qf[s2] = *(const bf16x8*)(qp + 16 * s2);
                if (nun > 1) { const int li1 = desc[4], c1 = desc[5], n1 = desc[6]; const int q1 = c1 * 256 + wave * 32 + r31;
                    ent_n = sel_list[(size_t)li1 * 8192 + ((q1 < n1) ? q1 : c1 * 256)]; }
            }
            asm volatile("s_waitcnt vmcnt(0)" ::: "memory");
            __builtin_amdgcn_sched_barrier(0);
            asm volatile("" : "+v"(qf[0]), "+v"(qf[1]), "+v"(qf[2]), "+v"(qf[3]), "+v"(ent_c), "+v"(ent_n));
            __builtin_amdgcn_sched_barrier(0);
            for (int k = 0; k < nun; ++k) {
                asm volatile("s_waitcnt lgkmcnt(0)\n\ts_barrier" ::: "memory");
                LAS unsigned char* kvb = lds + (k & 1) * 65536;
                unsigned ent_nn = 0;
#ifndef P4_NOMEM
#define P4_NOMEM 0
#endif
                if (k + 1 < nun && !(HASDRY && P4_NOMEM)) {
                    const int li1 = desc[(k + 1) * 4], bh1 = li1 >> 5, j1 = li1 & 31;
                    const bf16_t* qp = z + (size_t)((bh1 >> 3) * SEQ + (int)(ent_n & 8191u)) * ZLD + (bh1 & 7) * 64 + 8 * hh;
#pragma unroll
                    for (int s2 = 0; s2 < 4; ++s2) qn[s2] = *(const bf16x8*)(qp + 16 * s2);
                    if (k + 2 < nun) { const int li2 = desc[(k + 2) * 4], c2 = desc[(k + 2) * 4 + 1], n2 = desc[(k + 2) * 4 + 2]; const int q2 = c2 * 256 + wave * 32 + r31;
                        ent_nn = sel_list[(size_t)li2 * 8192 + ((q2 < n2) ? q2 : c2 * 256)]; }
                    asm volatile("" ::: "memory");
                    if (tid < 256) { const int dist = 255 - tid; tbr[((k + 1) & 1) * 256 + tid] = dist >= 128 ? 0.f : tabl[(bh1 & 7) * 132 + dist]; }
                    attn_stage_kv(lds + ((k + 1) & 1) * 65536, z, (bh1 >> 3) * SEQ + j1 * 256, bh1 & 7);
                    asm volatile("" ::: "memory");
                }
                const int li = desc[k * 4], cidx = desc[k * 4 + 1], n = desc[k * 4 + 2];
                const int bh = li >> 5, j = li & 31, hd = bh & 7;
                const int qbase = cidx * 256 + wave * 32;
                const bool act = qbase < n;
                float mx = 0.f, l = 1.f; f32x16 o[2];
                if (act) {
                    const int dbase = (int)(ent_c & 8191u) - j * 256;
                    const int dlo = wave_min_i32(dbase);
                    attn_unit<true, HASDRY ? ATTN_STUB : 0>(kvb, qf, dbase, dlo, 8, tbr + (k & 1) * 256, mx, l, o);
                }
                asm volatile("s_waitcnt vmcnt(0)" ::: "memory");
                __builtin_amdgcn_sched_barrier(0);
                asm volatile("" : "+v"(qn[0]), "+v"(qn[1]), "+v"(qn[2]), "+v"(qn[3]), "+v"(ent_nn));
                __builtin_amdgcn_sched_barrier(0);
                if (act) {
                    {
                        const bool valid = qbase + r31 < n;
                        const int sq = (int)(ent_c & 8191u), rank = (int)(ent_c >> 13);
                        const float inv = fast_rcp(l);
                        const unsigned pidx = valid ? (unsigned)(((size_t)bh * SEQ + sq) * 3 + rank) : 0xFFFFFFFFu;
                        LAS unsigned char* stg = lds + LDS_MISC + MISC_STG + wave * 2560;
#pragma unroll
                        for (int c = 0; c < 2; ++c) {
#pragma unroll
                            for (int g = 0; g < 4; ++g)
                                *(LAS u32x2*)(stg + r31 * 80 + (8 * g + 4 * hh) * 2) = (u32x2){pk2(o[c][4 * g] * inv, o[c][4 * g + 1] * inv), pk2(o[c][4 * g + 2] * inv, o[c][4 * g + 3] * inv)};
                            asm volatile("s_waitcnt lgkmcnt(0)" ::: "memory");
#pragma unroll
                            for (int i = 0; i < 2; ++i) {
                                const int row = i * 16 + (lane >> 2), chunk = lane & 3;
                                const u32x4 v = *(LAS u32x4*)(stg + row * 80 + chunk * 16);
                                const unsigned pr = (unsigned)__shfl((int)pidx, row);
                                if (pr != 0xFFFFFFFFu) *(u32x4*)(part_o + (size_t)pr * 64 + c * 32 + chunk * 8) = v;
                            }
                            asm volatile("s_waitcnt lgkmcnt(0)" ::: "memory");
                        }
                        if (valid && hh == 0) *(f32x2*)(part_ml + (size_t)pidx * 2) = (f32x2){mx + c31l[hd], l};
                    }
                }
                __builtin_amdgcn_sched_barrier(0);
                ent_c = ent_n; ent_n = ent_nn;
#pragma unroll
                for (int s2 = 0; s2 < 4; ++s2) qf[s2] = qn[s2];
            }
        }
        asm volatile("s_waitcnt vmcnt(0)" ::: "memory");
        __syncthreads();
    }
    }
    constexpr bool P5_PREFETCH = PH(4) && PH(5) && !HASDRY;
    if constexpr (!HASDRY) {
        if constexpr (P5_PREFETCH) {
            xcd_barrier(bar, [&]() {
                if (vcu < 256) {
                    const int uA = 2 * vcu, uB = 2 * vcu + 1;
                    attn_stage_kv_part(lds, z, ((uA >> 5) >> 3) * SEQ + (uA & 31) * 256, (uA >> 5) & 7, wave);
                    attn_stage_kv_part(lds + 65536, z, ((uB >> 5) >> 3) * SEQ + (uB & 31) * 256, (uB >> 5) & 7, wave);
                    if (wave == 1) {
                        attn_stage_kv_part(lds, z, ((uA >> 5) >> 3) * SEQ + (uA & 31) * 256, (uA >> 5) & 7, 0);
                        attn_stage_kv_part(lds + 65536, z, ((uB >> 5) >> 3) * SEQ + (uB & 31) * 256, (uB >> 5) & 7, 0);
                    }
                }
            });
        } else xcd_barrier(bar);
    }
    {
        unsigned char* wsl = (unsigned char*)karg_ptr(168);
        x = (const float*)karg_ptr(8 * 0);
        tab = (float*)(wsl + WS_TAB);
        z = (bf16_t*)(wsl + WS_Z);
        part_o = (bf16_t*)(wsl + WS_PARTO);
        part_ml = (float*)(wsl + WS_PARTML);
        ab = (bf16_t*)(wsl + WS_AB);
    }

    if constexpr (PH(5)) {
    {
        LAS float* tabl = (LAS float*)(lds + LDS_MISC + MISC_TAB);
        LAS float* tbr = (LAS float*)(lds + LDS_MISC + MISC_TBR);
        __syncthreads();
        for (int i = tid; i < 8 * 132; i += NT) tabl[i] = tab[i];
        for (int pr = vcu; pr < 256; pr += G) {
            const int half = wave >> 2, wl = wave & 3;
            __syncthreads();
            { const int hdp = ((2 * pr) >> 5) & 7, dist = 255 - tid; tbr[tid] = dist < 0 ? -INFINITY : (dist >= 128 ? 0.f : tabl[hdp * 132 + dist] - tabl[hdp * 132 + 128]); }
            if (!(P5_PREFETCH && pr == vcu)) {
                const int uA = 2 * pr, uB = 2 * pr + 1;
                attn_stage_kv(lds, z, ((uA >> 5) >> 3) * SEQ + (uA & 31) * 256, (uA >> 5) & 7);
                attn_stage_kv(lds + 65536, z, ((uB >> 5) >> 3) * SEQ + (uB & 31) * 256, (uB >> 5) & 7);
            }
            const int u = 2 * pr + half;
            const int bh = u >> 5, ob = u & 31, b = bh >> 3, hd = bh & 7;
            LAS unsigned char* kvb = lds + half * 65536;
            bf16x8 qs[4];
            {
                const bf16_t* qp = z + (size_t)(b * SEQ + ob * 256 + wl * 32 + r31) * ZLD + hd * 64 + 8 * hh;
#pragma unroll
                for (int s2 = 0; s2 < 4; ++s2) qs[s2] = *(const bf16x8*)(qp + 16 * s2);
            }
            asm volatile("s_waitcnt vmcnt(0)" ::: "memory");
            __syncthreads();
            const int nvalid = ob < 3 ? ob : 3;
#pragma unroll 1
            for (int pass = 0; pass < 2; ++pass) {
                const int qt = pass ? 7 - wl : wl;
                const int sq = ob * 256 + qt * 32 + r31;
                const size_t pbase = ((size_t)bh * SEQ + sq) * 3;
                float mr[3], lr[3];
#pragma unroll
                for (int r = 0; r < 3; ++r) { mr[r] = -INFINITY; lr[r] = 0.f; if (r < nvalid) { const f32x2 ml = *(const f32x2*)(part_ml + (pbase + r) * 2); mr[r] = ml.x; lr[r] = ml.y; } }
                float mx, l; f32x16 o[2];
                attn_unit<false, HASDRY ? ATTN_STUB : 0>(kvb, qs, qt * 32 + r31, qt * 32, qt + 1, tbr, mx, l, o);
                mx += tabl[hd * 132 + 128];
                if (pass == 0) {
                    const bf16_t* qp2 = z + (size_t)(b * SEQ + ob * 256 + (7 - wl) * 32 + r31) * ZLD + hd * 64 + 8 * hh;
#pragma unroll
                    for (int s2 = 0; s2 < 4; ++s2) qs[s2] = *(const bf16x8*)(qp2 + 16 * s2);
                }
                float M = mx;
#pragma unroll
                for (int r = 0; r < 3; ++r) M = fmaxf(M, mr[r]);
                const float wo = fast_exp2(mx - M);
                float wr[3], den = l * wo;
#pragma unroll
                for (int r = 0; r < 3; ++r) { wr[r] = (r < nvalid) ? lr[r] * fast_exp2(mr[r] - M) : 0.f; den += wr[r]; }
                const float inv = 1.0f / den;
                const float a_o = wo * inv, a_0 = wr[0] * inv, a_1 = wr[1] * inv, a_2 = wr[2] * inv;
                LAS unsigned char* stg = lds + LDS_MISC + MISC_STG + wave * 2560;
                const size_t prow0 = ((size_t)bh * SEQ + ob * 256 + qt * 32) * 3;
                bf16_t* op0 = ab + (size_t)(b * SEQ + ob * 256 + qt * 32) * D + hd * 64;
#pragma unroll
                for (int c = 0; c < 2; ++c) {
#pragma unroll
                    for (int g = 0; g < 4; ++g)
                        *(LAS u32x2*)(stg + r31 * 80 + (8 * g + 4 * hh) * 2) = (u32x2){pk2(o[c][4 * g] * a_o, o[c][4 * g + 1] * a_o), pk2(o[c][4 * g + 2] * a_o, o[c][4 * g + 3] * a_o)};
                    asm volatile("s_waitcnt lgkmcnt(0)" ::: "memory");
#pragma unroll
                    for (int i = 0; i < 2; ++i) {
                        const int row = i * 16 + (lane >> 2), chunk = lane & 3;
                        const u32x4 own = *(LAS u32x4*)(stg + row * 80 + chunk * 16);
                        float f[8] = {bflo(own.x), bfhi(own.x), bflo(own.y), bfhi(own.y), bflo(own.z), bfhi(own.z), bflo(own.w), bfhi(own.w)};
#pragma unroll
                        for (int r = 0; r < 3; ++r)
                            if (r < nvalid) {
                                const float ar = __shfl(r == 0 ? a_0 : (r == 1 ? a_1 : a_2), row);
                                const u32x4 w = *(const u32x4*)(part_o + (prow0 + (size_t)row * 3 + r) * 64 + c * 32 + chunk * 8);
                                f[0] += ar * bflo(w.x); f[1] += ar * bfhi(w.x); f[2] += ar * bflo(w.y); f[3] += ar * bfhi(w.y);
                                f[4] += ar * bflo(w.z); f[5] += ar * bfhi(w.z); f[6] += ar * bflo(w.w); f[7] += ar * bfhi(w.w);
                            }
                        *(u32x4*)(op0 + (size_t)row * D + c * 32 + chunk * 8) = (u32x4){pk2(f[0], f[1]), pk2(f[2], f[3]), pk2(f[4], f[5]), pk2(f[6], f[7])};
                    }
                    asm volatile("s_waitcnt lgkmcnt(0)" ::: "memory");
                }
            }
        }
        __syncthreads();
    }
    }
    if constexpr (!HASDRY) xcd_barrier(bar);
    {
        unsigned char* wsl = (unsigned char*)karg_ptr(168);
        x = (const float*)karg_ptr(8 * 0);
        g_ffn = (const float*)karg_ptr(8 * 8);
        w_gate = (const float*)karg_ptr(8 * 13);
        w_up = (const float*)karg_ptr(8 * 14);
        w_down = (const float*)karg_ptr(8 * 15);
        out = (float*)karg_ptr(160);
        ss1 = (float*)(wsl + WS_SS1P);
        WoutT = (bf16_t*)(wsl + WS_WOUT);
        xb = (bf16_t*)(wsl + WS_XB);
        WguT = (bf16_t*)(wsl + WS_Z);
        WdT = (bf16_t*)(wsl + WS_PARTO);
        ab = (bf16_t*)(wsl + WS_AB);
    }

    if constexpr (PH(6)) {
    {
        {
            SchedDense S6{64, 4, G, (int)blockIdx.x, 1024, (const unsigned char*)WoutT};
            gemm8(lds, (const unsigned char*)ab, 1024, S6, EpiX1{xb, ss1, dry});
        }
        __syncthreads();
        LAS float* tl = (LAS float*)lds;
        {
            f32x4 vc[8], vn[8];
            int it = vcu;
            if (it < 2048) { const int kind = it >> 10, r = it & 1023, e = r >> 5, tt = r & 31;
                transpose_load(vc, (kind ? w_up : w_gate) + (size_t)e * 1024 * 512, 512, (tt >> 1) * 64, (tt & 1) * 256); }
            for (; it < 2048; it += G) {
                const int nx = it + G;
                if (nx < 2048) { const int kind = nx >> 10, r = nx & 1023, e = r >> 5, tt = r & 31;
                    transpose_load(vn, (kind ? w_up : w_gate) + (size_t)e * 1024 * 512, 512, (tt >> 1) * 64, (tt & 1) * 256); }
                { const int kind = it >> 10, r = it & 1023, e = r >> 5, tt = r & 31;
                  transpose_finish(vc, 1024, WguT + (size_t)e * 1024 * 1024, (tt >> 1) * 64, (tt & 1) * 256, g_ffn, kind ? 2 : 1, tl); }
#pragma unroll
                for (int i = 0; i < 8; ++i) vc[i] = vn[i];
            }
        }
    }
    }
    if constexpr (!HASDRY) xcd_barrier(bar);
    {
        unsigned char* wsl = (unsigned char*)karg_ptr(168);
        cnt_exp = (unsigned*)(wsl + OFF_CNT_EXP);
        ss1 = (float*)(wsl + WS_SS1P);
        routeb = (float*)(wsl + WS_RB);
        WrT = (bf16_t*)(wsl + WS_WR);
        xb = (bf16_t*)(wsl + WS_XB);
        tok_list = (unsigned*)(wsl + WS_TOK);
        gate_list = (f32x2*)(wsl + WS_GW);
        rstd0 = (float*)(wsl + WS_RSTD0);
    }

    if constexpr (PH(7)) {
    {
        LAS float* lgp = (LAS float*)(lds + 98304);
        LAS unsigned char* wr_l = lds;
        LAS unsigned* hist = (LAS unsigned*)marr;
        __syncthreads();
#pragma unroll
        for (int i = 0; i < 12; ++i) {
            const int pc = wave * 12 + i, row = pc >> 1, dc = (pc & 1) * 64 + lane;
            __builtin_amdgcn_global_load_lds((const unsigned*)(WrT + (size_t)row * 1024 + (dc ^ (row & 7)) * 8), (LAS unsigned*)(wr_l + pc * 1024), 16, 0, 0);
        }
        asm volatile("s_waitcnt vmcnt(0)" ::: "memory");
        __syncthreads();
        for (int ug = vcu; ug < 256; ug += G) {
            __syncthreads();
            if (tid < 32) hist[tid] = 0u;
            const int grp = ug * 4 + (wave >> 1), khalf = wave & 1;
            const int m0 = grp * 16;
            f32x4 ac[3];
#pragma unroll
            for (int n = 0; n < 3; ++n) ac[n] = (f32x4){0.f, 0.f, 0.f, 0.f};
            const bf16_t* ap = xb + (size_t)(m0 + fr) * D + khalf * 512 + fq * 8;
            bf16x8 af[16];
#pragma unroll
            for (int ks = 0; ks < 16; ++ks) af[ks] = *(const bf16x8*)(ap + ks * 32);
#pragma unroll
            for (int ks = 0; ks < 16; ++ks) {
#pragma unroll
                for (int n = 0; n < 3; ++n) {
                    const int row = n * 16 + fr, ch = khalf * 64 + ks * 4 + fq;
                    const bf16x8 bf = *(LAS bf16x8*)(wr_l + row * 2048 + ((ch ^ (row & 7)) << 4));
                    ac[n] = mfma16(af[ks], bf, ac[n]);
                }
            }
#pragma unroll
            for (int n = 0; n < 3; ++n)
#pragma unroll
                for (int r = 0; r < 4; ++r) lgp[wave * 768 + (fq * 4 + r) * 48 + n * 16 + fr] = ac[n][r];
            __syncthreads();
            int e0 = 0, e1 = 0; float g0 = 0.f, g1 = 0.f, rs_tok = 0.f; unsigned lp0 = 0, lp1 = 0; int token = 0;
            const bool act = (khalf == 0) && (lane < 16);
            if (act) {
                token = m0 + lane;
                float ssum = 0.f;
                { const f32x4* pp4 = (const f32x4*)(ss1 + (size_t)token * 16); const f32x4 p0 = pp4[0], p1 = pp4[1], p2 = pp4[2], p3 = pp4[3];
                  ssum = ((p0.x + p0.y) + (p0.z + p0.w)) + ((p1.x + p1.y) + (p1.z + p1.w)) + ((p2.x + p2.y) + (p2.z + p2.w)) + ((p3.x + p3.y) + (p3.z + p3.w)); }
                const float rs = rsqrtf(ssum * (1.0f / D) + EPS); rs_tok = rs;
                if (!dry) rstd0[token] = rs;
                float lg[36];
#pragma unroll
                for (int c = 0; c < 36; ++c) lg[c] = (lgp[wave * 768 + lane * 48 + c] + lgp[(wave + 1) * 768 + lane * 48 + c]) * rs + routeb[c];
                int gs = 0; float gm = lg[0];
#pragma unroll
                for (int c = 1; c < 4; ++c) if (lg[c] > gm) { gm = lg[c]; gs = c; }
                float se = 0.f;
#pragma unroll
                for (int c = 0; c < 4; ++c) se += __expf(lg[c] - gm);
                const float pg = 1.0f / se;
                float l2[8];
#pragma unroll
                for (int c = 0; c < 8; ++c) l2[c] = gs == 0 ? lg[4 + c] : (gs == 1 ? lg[12 + c] : (gs == 2 ? lg[20 + c] : lg[28 + c]));
                int a0 = 0; float va = l2[0];
#pragma unroll
                for (int c = 1; c < 8; ++c) if (l2[c] > va) { va = l2[c]; a0 = c; }
                int a1 = -1; float vb = -INFINITY;
#pragma unroll
                for (int c = 0; c < 8; ++c) if (c != a0 && l2[c] > vb) { vb = l2[c]; a1 = c; }
                const float wa = 1.0f / (1.0f + __expf(vb - va));
                e0 = gs * 8 + a0; e1 = gs * 8 + a1; g0 = pg * wa; g1 = pg * (1.0f - wa);
                if (dry) { if (g0 + g1 == 12345.f) cnt_exp[0] = (unsigned)(e0 + e1); }
                else { lp0 = atomicAdd((unsigned*)&hist[e0], 1u);
                lp1 = atomicAdd((unsigned*)&hist[e1], 1u); }
            }
            __syncthreads();
            if (tid < 32) { const unsigned c = hist[tid]; hist[32 + tid] = c ? atomicAdd(&cnt_exp[tid], c) : 0u; }
            __syncthreads();
            if (act && !dry) {
                const unsigned p0 = hist[32 + e0] + lp0, p1 = hist[32 + e1] + lp1;
                tok_list[e0 * 16384 + p0] = (unsigned)token; gate_list[e0 * 16384 + p0] = (f32x2){g0, rs_tok};
                tok_list[e1 * 16384 + p1] = (unsigned)token | (1u << 14); gate_list[e1 * 16384 + p1] = (f32x2){g1, rs_tok};
            }
        }
    }
    }
    if constexpr (!HASDRY) xcd_barrier(bar);
    {
        unsigned char* wsl = (unsigned char*)karg_ptr(168);
        x = (const float*)karg_ptr(8 * 0);
        cnt_exp = (unsigned*)(wsl + OFF_CNT_EXP);
        ss1 = (float*)(wsl + WS_SS1P);
        xb = (bf16_t*)(wsl + WS_XB);
        WguT = (bf16_t*)(wsl + WS_Z);
        tok_list = (unsigned*)(wsl + WS_TOK);
        gate_list = (f32x2*)(wsl + WS_GW);
        hid = (bf16_t*)(wsl + WS_AB);
        w_down = (const float*)karg_ptr(8 * 15);
        WdT = (bf16_t*)(wsl + WS_PARTO);
        pb = (bf16_t*)(wsl + WS_PB);
        ppb = (bf16_t*)(wsl + WS_PP);
        WpleT = (bf16_t*)(wsl + WS_WPLE);
        rstd0 = (float*)(wsl + WS_RSTD0);
    }

    LAS int* ecnt = marr;
    LAS int* epre = marr + 32;
    LAS int* ehoff = marr + 72;
    __syncthreads();
    if (wave == 0) {
        const int c = lane < 32 ? (int)cnt_exp[lane] : 0;
        int tp2 = ((c + 255) >> 8) * 4, ho = c;
#pragma unroll
        for (int o2 = 1; o2 < 64; o2 <<= 1) { const int a2 = __shfl_up(tp2, o2), b2 = __shfl_up(ho, o2); if (lane >= o2) { tp2 += a2; ho += b2; } }
        if (lane < 32) { ecnt[lane] = c; epre[lane + 1] = tp2; ehoff[lane + 1] = ho; }
        if (lane == 0) { epre[0] = 0; ehoff[0] = 0; }
    }
    __syncthreads();
    if constexpr (PH(8)) {
        SchedMoe S8{ecnt, epre, ehoff, G, (int)blockIdx.x, 1024, (const unsigned char*)WguT, (size_t)1024 * 1024 * 2, tok_list, 0};
        gemm8(lds, (const unsigned char*)xb, 1024, S8, EpiHid{hid, gate_list, ehoff});
        {
            const int nwg8 = epre[32], c8 = (int)blockIdx.x;
            const int nmax = (nwg8 + G - 1) / G, nheavy = nwg8 - (nmax - 1) * G;
            const int nlight = nheavy >= G ? G : G - nheavy, li = nheavy >= G ? c8 : c8 - nheavy;
            if (li >= 0) {
                f32x4 vc[8], vn[8];
                int it = li;
                if (it < 1024) { const int e = it >> 5, tt = it & 31; transpose_load(vc, w_down + (size_t)e * 512 * 1024, 1024, (tt >> 2) * 64, (tt & 3) * 256); }
                for (; it < 1024; it += nlight) {
                    const int nx = it + nlight;
                    if (nx < 1024) { const int e = nx >> 5, tt = nx & 31; transpose_load(vn, w_down + (size_t)e * 512 * 1024, 1024, (tt >> 2) * 64, (tt & 3) * 256); }
                    { const int e = it >> 5, tt = it & 31; transpose_finish(vc, 512, WdT + (size_t)e * 1024 * 512, (tt >> 2) * 64, (tt & 3) * 256, nullptr, 0, (LAS float*)lds); }
#pragma unroll
                    for (int i = 0; i < 8; ++i) vc[i] = vn[i];
                }
            }
        }
    }
    if constexpr (!HASDRY) xcd_barrier(bar);
    {
        unsigned char* wsl = (unsigned char*)karg_ptr(168);
        x = (const float*)karg_ptr(8 * 0);
        yslot = (bf16_t*)(wsl + WS_Z);
        tok_list = (unsigned*)(wsl + WS_TOK);
        WdT = (bf16_t*)(wsl + WS_PARTO);
        hid = (bf16_t*)(wsl + WS_AB);
        pb = (bf16_t*)(wsl + WS_PB);
        ppb = (bf16_t*)(wsl + WS_PP);
        WpleT = (bf16_t*)(wsl + WS_WPLE);
    }
    if constexpr (PH(9)) {
        SchedMoe S9{ecnt, epre, ehoff, G, (int)blockIdx.x, 512, (const unsigned char*)WdT, (size_t)1024 * 512 * 2, tok_list, 1};
        gemm8(lds, (const unsigned char*)hid, 512, S9, EpiY{yslot, tok_list});
        {
            const int nwg9 = epre[32], c9 = (int)blockIdx.x;
            const int nmax = (nwg9 + G - 1) / G, nheavy = nwg9 - (nmax - 1) * G;
            const int nlight = nheavy >= G ? G : G - nheavy, li = nheavy >= G ? c9 : c9 - nheavy;
            SchedLight S2{64, 4, 256, li, nlight, li >= 0, (const unsigned char*)WpleT};
            gemm8(lds, (const unsigned char*)pb, 256, S2, EpiBf16Plain{ppb, D});
        }
    }
    if constexpr (!HASDRY) xcd_barrier(bar);
    {
        unsigned char* wsl = (unsigned char*)karg_ptr(168);
        x = (const float*)karg_ptr(8 * 0);
        out = (float*)karg_ptr(160);
        rstd2 = (float*)(wsl + WS_RSTD2);
        xb = (bf16_t*)(wsl + WS_XB);
        z = (bf16_t*)(wsl + WS_Z);
        yslot = (bf16_t*)(wsl + WS_Z);
    }

    if constexpr (PH(10)) {
    for (int row = (vcu * 8 + wave) * 2; row < T; row += G * 16) {
        u32x2* xr = (u32x2*)(xb + (size_t)row * D) + lane;
        const u32x2* y0 = (const u32x2*)(yslot + (size_t)row * D) + lane;
        const u32x2* y1 = (const u32x2*)(yslot + ((size_t)T + row) * D) + lane;
        u32x2 xv[8], a[8], c[8];
#pragma unroll
        for (int j = 0; j < 8; ++j) { xv[j] = xr[64 * j]; a[j] = y0[64 * j]; c[j] = y1[64 * j]; }
        float s0 = 0.f, s1 = 0.f;
#pragma unroll
        for (int j = 0; j < 8; ++j) {
            const float vx = bflo(xv[j].x) + bflo(a[j].x) + bflo(c[j].x), vy = bfhi(xv[j].x) + bfhi(a[j].x) + bfhi(c[j].x);
            const float vz = bflo(xv[j].y) + bflo(a[j].y) + bflo(c[j].y), vw = bfhi(xv[j].y) + bfhi(a[j].y) + bfhi(c[j].y);
            if (!dry) xr[64 * j] = (u32x2){pk2(vx, vy), pk2(vz, vw)};
            const float q = (vx * vx + vy * vy) + (vz * vz + vw * vw);
            if (j < 4) s0 += q; else s1 += q;
        }
        s0 = wave_sum(s0); s1 = wave_sum(s1);
        if (lane == 0 && !dry) { rstd2[row] = rsqrtf(s0 * (1.0f / D) + EPS); rstd2[row + 1] = rsqrtf(s1 * (1.0f / D) + EPS); }
    }
    }
    if constexpr (!HASDRY) xcd_barrier(bar);
    {
        unsigned char* wsl = (unsigned char*)karg_ptr(168);
        x = (const float*)karg_ptr(8 * 0);
        out = (float*)karg_ptr(160);
        ss3 = (float*)(wsl + OFF_SS3);
        rstd2 = (float*)(wsl + WS_RSTD2);
        WpgT = (bf16_t*)(wsl + WS_WPG);
        xb = (bf16_t*)(wsl + WS_XB);
        ppb = (bf16_t*)(wsl + WS_PP);
        g_final = (const float*)karg_ptr(8 * 19);
    }

    if constexpr (PH(11)) {
    {
        SchedDense S11{64, 4, G, (int)blockIdx.x, 1024, (const unsigned char*)WpgT};
        if (G == 256) gemm8(lds, (const unsigned char*)xb, 1024, S11, EpiX3F{xb, out, ppb, rstd2, ss3, (unsigned*)(ws + OFF_PCNT), g_final});
        else gemm8(lds, (const unsigned char*)xb, 1024, S11, EpiX3{xb, out, ppb, rstd2, ss3, dry});
    }
    }
    if constexpr (!HASDRY) { if (G != 256) xcd_barrier(bar); }
    {
        unsigned char* wsl = (unsigned char*)karg_ptr(168);
        g_final = (const float*)karg_ptr(8 * 19);
        out = (float*)karg_ptr(160);
        ss3 = (float*)(wsl + OFF_SS3);
    }

    if constexpr (PH(13) || PH(14)) {
        unsigned char* wsl = (unsigned char*)karg_ptr(168);
        struct EpiNull { float* o; DI void operator()(const f32x4 (&acc)[2][2][4][2], const GUnit& u, int wr, int wc, int fr, int fq) const {
            f32x4 t = acc[0][0][0][0];
#pragma unroll
            for (int a = 0; a < 2; ++a)
#pragma unroll
                for (int b = 0; b < 2; ++b)
#pragma unroll
                    for (int m = 0; m < 4; ++m)
#pragma unroll
                        for (int n = 0; n < 2; ++n) t += acc[a][b][m][n];
            if (t.x + t.y + t.z + t.w == 12345.678f) o[threadIdx.x] = t.x; } };
        SchedDense S13{64, 4, G, (int)blockIdx.x, PH(14) ? 512 : 1024, (const unsigned char*)(wsl + WS_WPG)};
        gemm8<PH(14)>(lds, (const unsigned char*)(wsl + WS_XB), PH(14) ? 512 : 1024, S13, EpiNull{(float*)(wsl + WS_SS1P)});
    }

    if constexpr (PH(12)) {
    if (G != 256)
    for (int row = vcu * 8 + wave; row < T; row += G * 8) {
        f32x4* xr = (f32x4*)(out + (size_t)row * D) + lane;
        const f32x4* gf = (const f32x4*)g_final + lane;
        const float rs = rsqrtf(ss3[row] * (1.0f / D) + EPS);
#pragma unroll
        for (int j = 0; j < 4; ++j) { f32x4 v = xr[64 * j]; const f32x4 g = gf[64 * j]; v = v * rs * g; if (!dry) xr[64 * j] = v; }
    }
    }
}

extern "C" void kernel_launch(void* const* d_in, const int* in_sizes, int n_in, void* d_out, int out_size, void* d_ws, size_t ws_size, hipStream_t stream) {
    static int grid = 0;
    if (grid == 0) {
        int dev = 0, cus = 0, per_cu = 0;
        if (n_in != 20 || out_size != T * D || ws_size < WS_END) { fprintf(stderr, "kernel_launch: unexpected shapes (n_in %d out %d ws %zu)\n", n_in, out_size, ws_size); grid = -1; return; }
        if (hipGetDevice(&dev) != hipSuccess || hipDeviceGetAttribute(&cus, hipDeviceAttributeMultiprocessorCount, dev) != hipSuccess) { grid = -1; return; }
        if (hipFuncSetAttribute((const void*)hymba_fwd<0x1FFFu, false>, hipFuncAttributeMaxDynamicSharedMemorySize, LDS_BYTES) != hipSuccess) { fprintf(stderr, "kernel_launch: hipFuncSetAttribute failed\n"); grid = -1; return; }
        if (hipOccupancyMaxActiveBlocksPerMultiprocessor(&per_cu, (const void*)hymba_fwd<0x1FFFu, false>, NT, LDS_BYTES) != hipSuccess || per_cu < 1) { fprintf(stderr, "kernel_launch: occupancy query says %d blocks per CU\n", per_cu); (void)hipGetLastError(); grid = -1; return; }
        grid = cus;
    }
    if (grid < 0) return;
    (void)hipMemsetAsync((char*)d_ws + WS_CTL, 0, CTL_BYTES, stream);
    Params p{};
    for (int i = 0; i < 20; ++i) p.in[i] = (const float*)d_in[i];
    p.out = (float*)d_out; p.ws = (unsigned char*)d_ws;
    hipLaunchKernelGGL((hymba_fwd<0x1FFFu, false>), dim3(grid), dim3(NT), LDS_BYTES, stream, p);
#if PROF_PHASES
    p.dry = 1;
#define PROF_ONE(k) do { if (PROF_PHASES & (1u << (k))) { (void)hipFuncSetAttribute((const void*)hymba_fwd<(1u << (k)), true>, hipFuncAttributeMaxDynamicSharedMemorySize, LDS_BYTES); \
        hipLaunchKernelGGL((hymba_fwd<(1u << (k)), true>), dim3(grid), dim3(NT), LDS_BYTES, stream, p); } } while (0)
    PROF_ONE(0); PROF_ONE(1); PROF_ONE(2); PROF_ONE(3); PROF_ONE(4); PROF_ONE(5); PROF_ONE(6); PROF_ONE(7); PROF_ONE(8); PROF_ONE(9); PROF_ONE(10); PROF_ONE(11); PROF_ONE(12); PROF_ONE(13); PROF_ONE(14);
#endif
}
```
